# Optimizing an MI355X kernel written in HIP

```python
import math
import jax, jax.numpy as jnp
from jax import lax
import numpy as np

D_MODEL = 2048
BATCH = 1
SEQ = 16384
DEPTH = 1

HEAD_DIM = 64
N_Q_HEADS = 16
N_KV_HEADS = 2
Q_PER_KV = N_Q_HEADS // N_KV_HEADS
D_ATTN = N_Q_HEADS * HEAD_DIM
D_KV = N_KV_HEADS * HEAD_DIM
D_CONV = D_MODEL - D_ATTN
D_MIX = D_ATTN + D_CONV
D_IN = D_ATTN + 2 * D_KV + 2 * D_CONV
WINDOW = 128
BLOCK = 128
CONV_WIDTH = 31
N_BUCKETS = 32
MAX_DISTANCE = 128
N_EXPERTS = 32
TOP_K = 4
D_FF = D_MODEL
SWIGLU_LIMIT = 7.0
SWIGLU_ALPHA = 1.702
MOE_BLOCK = 128
EPS = 1e-6
NEG_INF = -1e30

kernel_name = "hymba_swa_conformer_moe_adaln"


def rms_norm(x, g):
    xf = x.astype(jnp.float32)
    y = xf * lax.rsqrt(jnp.mean(xf * xf, axis=-1, keepdims=True) + EPS)
    return (y * g.astype(jnp.float32)).astype(x.dtype)


def layer_norm(x, g, b):
    xf = x.astype(jnp.float32)
    mu = jnp.mean(xf, axis=-1, keepdims=True)
    var = jnp.mean(jnp.square(xf - mu), axis=-1, keepdims=True)
    y = (xf - mu) * lax.rsqrt(var + EPS)
    return (y * g.astype(jnp.float32) + b.astype(jnp.float32)).astype(x.dtype)


def t5_causal_bucket(dist):
    max_exact = N_BUCKETS // 2
    d = jnp.maximum(dist, 0)
    log_ratio = jnp.log(jnp.maximum(d, max_exact).astype(jnp.float32) / max_exact)
    large = max_exact + (log_ratio / math.log(MAX_DISTANCE / max_exact)
                         * (N_BUCKETS - max_exact)).astype(jnp.int32)
    large = jnp.minimum(large, N_BUCKETS - 1)
    return jnp.where(d < max_exact, d, large)


def sliding_window_attention(q, k, v, g_q, g_k, sinks, rel_bias):
    B, T = q.shape[0], q.shape[1]
    nb = T // BLOCK
    q = rms_norm(q, g_q)
    k = rms_norm(k, g_k)
    qb = q.reshape(B, nb, BLOCK, N_KV_HEADS, Q_PER_KV, HEAD_DIM)

    def with_prev(t):
        tb = t.reshape(B, nb, BLOCK, N_KV_HEADS, HEAD_DIM)
        prev = jnp.pad(tb[:, :-1], ((0, 0), (1, 0), (0, 0), (0, 0), (0, 0)))
        return jnp.concatenate([prev, tb], axis=2)

    kb = with_prev(k)
    vb = with_prev(v)
    scores = jnp.einsum('bnqhgd,bnkhd->bnhgqk', qb, kb).astype(jnp.float32) * (HEAD_DIM ** -0.5)

    q_local = jnp.arange(BLOCK, dtype=jnp.int32) + BLOCK
    k_local = jnp.arange(2 * BLOCK, dtype=jnp.int32)
    dist = q_local[:, None] - k_local[None, :]
    band = (dist >= 0) & (dist < WINDOW)
    has_prev = (jnp.arange(nb)[:, None, None] > 0) | (k_local >= BLOCK)[None, None, :]
    valid = band[None] & has_prev

    bias = rel_bias.astype(jnp.float32)[t5_causal_bucket(dist)]
    bias = jnp.transpose(bias, (2, 0, 1)).reshape(N_KV_HEADS, Q_PER_KV, BLOCK, 2 * BLOCK)
    scores = jnp.where(valid[None, :, None, None], scores + bias[None, None], NEG_INF)

    s = sinks.astype(jnp.float32).reshape(N_KV_HEADS, Q_PER_KV)[None, None, :, :, None, None]
    m = jnp.maximum(jnp.max(scores, axis=-1, keepdims=True), s)
    p = jnp.exp(scores - m)
    p = p / (jnp.sum(p, axis=-1, keepdims=True) + jnp.exp(s - m))
    out = jnp.einsum('bnhgqk,bnkhd->bnqhgd', p.astype(vb.dtype), vb)
    return out.reshape(B, T, N_Q_HEADS * HEAD_DIM)


def conformer_conv(u, w_dw, b_dw, ln_g, ln_b):
    a, gate = jnp.split(u, 2, axis=-1)
    h = a * jax.nn.sigmoid(gate)
    h = lax.conv_general_dilated(
        h, w_dw[:, None, :].astype(h.dtype), window_strides=(1,),
        padding=[(CONV_WIDTH - 1, 0)],
        dimension_numbers=('NWC', 'WIO', 'NWC'),
        feature_group_count=D_CONV) + b_dw
    h = layer_norm(h, ln_g, ln_b)
    return jax.nn.silu(h)


def moe_ffn(h, w_router, b_router, w_gate, b_gate, w_up, b_up, w_down, b_down):
    B, T, D = h.shape
    n_tok = B * T
    xt = h.reshape(n_tok, D)
    logits = (xt @ w_router + b_router).astype(jnp.float32)
    top_val, top_idx = lax.top_k(logits, TOP_K)
    top_w = jax.nn.softmax(top_val, axis=-1)

    n_assign = n_tok * TOP_K
    expert_flat = top_idx.reshape(-1).astype(jnp.int32)
    token_flat = jnp.repeat(jnp.arange(n_tok, dtype=jnp.int32), TOP_K)
    weight_flat = top_w.reshape(-1)
    order = jnp.argsort(expert_flat)
    exp_sorted = expert_flat[order]
    tok_sorted = token_flat[order]
    w_sorted = weight_flat[order]

    counts = jnp.bincount(expert_flat, length=N_EXPERTS)
    padded = ((counts + MOE_BLOCK - 1) // MOE_BLOCK) * MOE_BLOCK
    start = jnp.cumsum(counts) - counts
    pend = jnp.cumsum(padded)
    pstart = pend - padded
    dest = pstart[exp_sorted] + (jnp.arange(n_assign, dtype=jnp.int32) - start[exp_sorted])

    n_rows = ((n_assign + MOE_BLOCK - 1) // MOE_BLOCK) * MOE_BLOCK + N_EXPERTS * MOE_BLOCK
    n_blocks = n_rows // MOE_BLOCK
    row_tok = jnp.full((n_rows,), n_tok, jnp.int32).at[dest].set(tok_sorted)
    row_w = jnp.zeros((n_rows,), jnp.float32).at[dest].set(w_sorted)
    block_expert = jnp.minimum(
        jnp.searchsorted(pend, jnp.arange(n_blocks, dtype=jnp.int32) * MOE_BLOCK, side='right'),
        N_EXPERTS - 1).astype(jnp.int32)

    x_pad = jnp.concatenate([xt, jnp.zeros((1, D), xt.dtype)], axis=0)

    def expert_block(args):
        tok, e = args
        xb = x_pad[tok]
        g = xb @ w_gate[e] + b_gate[e]
        lin = xb @ w_up[e] + b_up[e]
        g = jnp.minimum(g, SWIGLU_LIMIT)
        lin = jnp.clip(lin, -SWIGLU_LIMIT, SWIGLU_LIMIT)
        act = g * jax.nn.sigmoid(SWIGLU_ALPHA * g) * (lin + 1.0)
        return act @ w_down[e] + b_down[e]

    out_rows = lax.map(expert_block, (row_tok.reshape(n_blocks, MOE_BLOCK), block_expert))
    out_rows = out_rows.reshape(n_rows, D) * row_w[:, None].astype(out_rows.dtype)
    y = jnp.zeros((n_tok + 1, D), out_rows.dtype).at[row_tok].add(out_rows)[:n_tok]
    return y.reshape(B, T, D)


def setup_inputs(seed: int = 0) -> dict:
    key = jax.random.key(seed)
    ks = jax.random.split(key, 32)
    f32 = jnp.float32
    L, D, E, F = DEPTH, D_MODEL, N_EXPERTS, D_FF

    def nrm(k, shape, scale):
        return jax.random.normal(k, shape, f32) * scale

    return {
        "x": nrm(ks[0], (BATCH, SEQ, D), 1.0),
        "c": nrm(ks[1], (BATCH, D), 1.0),
        "w_ada": nrm(ks[2], (L, D, 6 * D), 0.5 * D ** -0.5),
        "b_ada": nrm(ks[3], (L, 6 * D), 0.02),
        "g_norm1": 1.0 + nrm(ks[4], (L, D), 0.02),
        "w_in": nrm(ks[5], (L, D, D_IN), D ** -0.5),
        "b_in": nrm(ks[6], (L, D_IN), 0.02),
        "g_q": 1.0 + nrm(ks[7], (L, HEAD_DIM), 0.02),
        "g_k": 1.0 + nrm(ks[8], (L, HEAD_DIM), 0.02),
        "sinks": nrm(ks[9], (L, N_Q_HEADS), 1.0),
        "rel_bias": nrm(ks[10], (N_BUCKETS, N_Q_HEADS), 0.5),
        "w_dw": nrm(ks[11], (L, CONV_WIDTH, D_CONV), CONV_WIDTH ** -0.5),
        "b_dw": nrm(ks[12], (L, D_CONV), 0.02),
        "ln_g": 1.0 + nrm(ks[13], (L, D_CONV), 0.02),
        "ln_b": nrm(ks[14], (L, D_CONV), 0.02),
        "g_out_attn": 1.0 + nrm(ks[15], (L, D_ATTN), 0.02),
        "g_out_conv": 1.0 + nrm(ks[16], (L, D_CONV), 0.02),
        "w_out": nrm(ks[17], (L, D_MIX, D), D_MIX ** -0.5),
        "b_out": nrm(ks[18], (L, D), 0.02),
        "g_norm2": 1.0 + nrm(ks[19], (L, D), 0.02),
        "w_router": nrm(ks[20], (L, D, E), D ** -0.5),
        "b_router": nrm(ks[21], (L, E), 0.01),
        "w_gate": nrm(ks[22], (L, E, D, F), D ** -0.5),
        "b_gate": nrm(ks[23], (L, E, F), 0.02),
        "w_up": nrm(ks[24], (L, E, D, F), D ** -0.5),
        "b_up": nrm(ks[25], (L, E, F), 0.02),
        "w_down": nrm(ks[26], (L, E, F, D), F ** -0.5),
        "b_down": nrm(ks[27], (L, E, D), 0.02),
    }


def reference(x, c, w_ada, b_ada, g_norm1, w_in, b_in, g_q, g_k, sinks, rel_bias,
              w_dw, b_dw, ln_g, ln_b, g_out_attn, g_out_conv, w_out, b_out, g_norm2,
              w_router, b_router, w_gate, b_gate, w_up, b_up, w_down, b_down):
    B, T, _ = x.shape
    for l in range(DEPTH):
        mod = jax.nn.silu(c) @ w_ada[l] + b_ada[l]
        shift1, scale1, gate1, shift2, scale2, gate2 = jnp.split(mod[:, None, :], 6, axis=-1)

        h = rms_norm(x, g_norm1[l]) * (1.0 + scale1) + shift1
        u = h @ w_in[l] + b_in[l]
        q = u[..., :D_ATTN].reshape(B, T, N_Q_HEADS, HEAD_DIM)
        k = u[..., D_ATTN:D_ATTN + D_KV].reshape(B, T, N_KV_HEADS, HEAD_DIM)
        v = u[..., D_ATTN + D_KV:D_ATTN + 2 * D_KV].reshape(B, T, N_KV_HEADS, HEAD_DIM)
        u_conv = u[..., D_ATTN + 2 * D_KV:]

        y_attn = sliding_window_attention(q, k, v, g_q[l], g_k[l], sinks[l], rel_bias)
        y_conv = conformer_conv(u_conv, w_dw[l], b_dw[l], ln_g[l], ln_b[l])
        mixed = jnp.concatenate([rms_norm(y_attn, g_out_attn[l]),
                                 rms_norm(y_conv, g_out_conv[l])], axis=-1)
        x = x + gate1 * (mixed @ w_out[l] + b_out[l])

        h2 = rms_norm(x, g_norm2[l]) * (1.0 + scale2) + shift2
        y_moe = moe_ffn(h2, w_router[l], b_router[l], w_gate[l], b_gate[l],
                        w_up[l], b_up[l], w_down[l], b_down[l])
        x = x + gate2 * y_moe
    return x
```

```cpp
#include <hip/hip_runtime.h>
#include <cstdio>
#include <cstdint>

#ifdef FORCE_OV
#define GU_MAIN(t) ((t) - FORCE_OV)
#else
#define GU_MAIN(t) (((t) / F.G) * F.G)
#endif
#ifndef MK_N_LAUNCHES
#define MK_N_LAUNCHES 1
#endif

#define LAS __attribute__((address_space(3)))
#define GAS __attribute__((address_space(1)))
typedef unsigned short bf16;
typedef short bf16x8 __attribute__((ext_vector_type(8)));
typedef short s16x4 __attribute__((ext_vector_type(4)));
typedef float f32x4 __attribute__((ext_vector_type(4)));
typedef float f32x2 __attribute__((ext_vector_type(2)));
typedef unsigned u32x4 __attribute__((ext_vector_type(4)));
typedef unsigned u32x2 __attribute__((ext_vector_type(2)));
typedef int i32x4 __attribute__((ext_vector_type(4)));
typedef int i32x8 __attribute__((ext_vector_type(8)));
constexpr int W8_SHIFT = 5; constexpr int W8_SCALE_E8 = (127 - W8_SHIFT) * 0x01010101; constexpr float W8_MUL = 32.0f;
__device__ __forceinline__ unsigned pk_hi_lo_fp8(f32x2 lo, f32x2 hi) { unsigned w = __builtin_amdgcn_cvt_pk_fp8_f32(hi.x, hi.y, __float_as_uint(hi.x), true); return __builtin_amdgcn_cvt_pk_fp8_f32(lo.x, lo.y, w, false); }
__device__ __forceinline__ unsigned pk4_fp8(float a, float b, float c, float d) { unsigned w = 0u; w = __builtin_amdgcn_cvt_pk_fp8_f32(a, b, w, false); w = __builtin_amdgcn_cvt_pk_fp8_f32(c, d, w, true); return w; }

constexpr int T = 16384, D = 2048, DIN = 3328, DA = 1024, DKV = 128, DC = 1024, NE = 32, NH = 16;
constexpr int LCAP = 16384;
constexpr float EPS = 1e-6f, LOG2E = 1.4426950408889634f, QSCALE = 0.125f * 1.4426950408889634f;
constexpr int NPHASE = 10;

constexpr size_t MiB = 1u << 20;
constexpr size_t WS_CTL = 0, CTL_BYTES = 1 * MiB, CTL_ZERO_BYTES = 64 * 1024;
constexpr size_t WS_WIN = 2 * MiB;
constexpr size_t WS_WOUT = 16 * MiB;
constexpr size_t WS_MISC = 24 * MiB;
constexpr size_t WS_H = 32 * MiB;
constexpr size_t WS_Q = 96 * MiB;
constexpr size_t WS_K = 128 * MiB;
constexpr size_t WS_V = 132 * MiB;
constexpr size_t WS_GLU = 136 * MiB;
constexpr size_t WS_MIX = 168 * MiB;
constexpr size_t WS_WGU = 256 * MiB;
constexpr size_t WS_WDN = 512 * MiB;
constexpr size_t WS_ACT = 640 * MiB;
constexpr size_t WS_PART = 784 * MiB;
constexpr size_t WS_H8 = 1040 * MiB;
constexpr size_t WS_LIST = 1072 * MiB;
constexpr size_t WS_END = 1080 * MiB;
constexpr int CW_TMO = 0;
constexpr int CW_BAR = 4096;
constexpr int CW_CNT = 8192;
constexpr int CW_OVF = 10240;
constexpr int CW_MOD = 16384;
constexpr int CW_CVR = 28672;
constexpr int CW_CVGU = 65536;
static_assert((CW_CVGU + 32 * 4096) * 4 <= (int)CTL_BYTES && (CW_CNT + 32 * 64) * 4 <= (int)CTL_ZERO_BYTES && (CW_BAR + 3456) * 4 <= (int)CTL_ZERO_BYTES, "ctl");
constexpr size_t MS_BIASP = 0;
constexpr size_t MS_RA = 64 * 1024;
constexpr size_t MS_TOPW = 256 * 1024;
constexpr size_t MS_WR2 = 1 * MiB;
constexpr size_t MS_LIST = 2 * MiB;
constexpr size_t MS_MODP = 6 * MiB;

constexpr int RING_BYTES = 131072;
constexpr int META_OFF = 131840;
constexpr int MISC_OFF = 142336;
constexpr int LDS_BYTES = 143360;
constexpr int P3_K = 0, P3_V = 55296, P3_TAB = 110592, P3_SSQ = 118784, P3_RA = 131584, P3_CTP = 1028;

#define LDS_WAIT() asm volatile("s_waitcnt lgkmcnt(0)" ::: "memory")
#define VM_WAIT() asm volatile("s_waitcnt vmcnt(0)" ::: "memory")
#define RLX_AGENT __ATOMIC_RELAXED, __HIP_MEMORY_SCOPE_AGENT

__device__ __forceinline__ unsigned cvt_pk_bf16(float lo, float hi) { unsigned r; asm volatile("v_cvt_pk_bf16_f32 %0, %1, %2" : "=v"(r) : "v"(lo), "v"(hi)); return r; }
__device__ __forceinline__ float wave_sum(float v) {
#pragma unroll
    for (int o = 1; o < 64; o <<= 1) v += __shfl_xor(v, o);
    return v;
}
__device__ __forceinline__ void wave_sum4(float (&v)[4]) {
#pragma unroll
    for (int o = 1; o < 64; o <<= 1) {
#pragma unroll
        for (int k = 0; k < 4; ++k) v[k] += __shfl_xor(v[k], o); }
}
__device__ __forceinline__ float bf_lo(unsigned v) { return __builtin_bit_cast(float, v << 16); }
__device__ __forceinline__ float bf_hi(unsigned v) { return __builtin_bit_cast(float, v & 0xffff0000u); }

namespace pg8 {
constexpr int BM = 256, BK = 64, HALF = 128, HTB = HALF * BK * 2, STAGE_BYTES = 8 * HTB, NXCD = 8, WGM = 8;
constexpr int KB16 = 4096, KB8 = 2048;
__host__ __device__ __forceinline__ int lds_byte(int r, int c) { const int st = (r >> 4) * 2 + (c >> 5), rr = r & 15, cc = c & 31, ob = rr * 64 + cc * 2; return st * 1024 + (ob ^ (((ob >> 9) & 1) << 5)); }
__host__ __device__ __forceinline__ void stage_rc(int b, int& R, int& C) { const int st = b / 1024, sb = b % 1024, swz = sb ^ (((sb >> 9) & 1) << 5); R = (st >> 1) * 16 + swz / 64; C = (st & 1) * 32 + (swz % 64) / 2; }
__host__ __device__ __forceinline__ int perm32(int rho) { const int n = rho >> 4, i = rho & 15; return 8 * (i >> 2) + 4 * n + (i & 3); }

struct Unit { int pm, pn, e, m, nv, nt; };
constexpr size_t KSTEP = 128;

template <int KB> struct DenseOrderT {
    static constexpr bool META = false, DEP = false;
    static constexpr size_t HSTEP = (size_t)HALF * KB, TSTEP = 2 * HSTEP;
    const char* A; const char* Bt; int nM, nN, nwg, G, c;
    __device__ void init(const void* A_, const void* Bt_, int M, int N, int G_, int c_) { A = (const char*)A_; Bt = (const char*)Bt_; nM = M / BM; nN = N / BM; nwg = nM * nN; G = G_; c = c_; }
    __device__ __forceinline__ bool next(int i, Unit& u) const {
        const int L = i * G + c; if (L >= nwg) return false;
        int wgid = L; { const int q = nwg / NXCD, r = nwg % NXCD, xcd = wgid % NXCD, off = wgid / NXCD; wgid = (xcd < r ? xcd * (q + 1) : r * (q + 1) + (xcd - r) * q) + off; }
        const int nig = WGM * nN, gid = wgid / nig, fm = gid * WGM, gsz = (nM - fm) < WGM ? (nM - fm) : WGM;
        u.pm = fm + ((wgid % nig) % gsz); u.pn = (wgid % nig) / gsz; u.e = 0; u.m = 0; u.nv = 256; u.nt = 1; return true;
    }
    __device__ __forceinline__ const char* a_base(const Unit& u) const { return A + (size_t)u.pm * TSTEP; }
    __device__ __forceinline__ const char* b_base(const Unit& u) const { return Bt + (size_t)u.pn * TSTEP; }
    __device__ __forceinline__ void a_off(const Unit&, unsigned (&v)[2][2], int tid, const LAS unsigned char*) const {
        int R[2], C[2]; stage_rc(tid * 16, R[0], C[0]); stage_rc(tid * 16 + 8192, R[1], C[1]);
#pragma unroll
        for (int h = 0; h < 2; ++h)
#pragma unroll
            for (int i = 0; i < 2; ++i) v[h][i] = (unsigned)(h * (int)HSTEP) + (unsigned)(R[i] * KB + C[i] * 2);
    }
    __device__ __forceinline__ void meta_issue(const Unit&, LAS unsigned char*, LAS unsigned char*, int, int) const {}
};
typedef DenseOrderT<KB16> DenseOrder;
template <int KB> struct MoeOrderT {
    static constexpr bool META = true;
    static constexpr size_t HSTEP = (size_t)HALF * KB, TSTEP = 2 * HSTEP;
    const LAS int* tab; int npn, G, c, total;
    const char* A; const char* Bt; size_t bexp; const u32x4* list; const float* cbase; int cexp;
    __device__ __forceinline__ bool next(int i, Unit& u) const {
        const int L = i * G + c; if (L >= total) return false;
        int e = 0;
        for (int j = 1; j < 32; ++j) e += (L >= tab[32 + j]) ? 1 : 0;
        e = __builtin_amdgcn_readfirstlane(e);
        const int p0 = __builtin_amdgcn_readfirstlane(tab[32 + e]), p1 = __builtin_amdgcn_readfirstlane(tab[33 + e]);
        const int cnt = __builtin_amdgcn_readfirstlane(tab[e]), t0 = __builtin_amdgcn_readfirstlane(tab[65 + e]);
        const int nt = (p1 - p0) / npn, rem = L - p0;
        u.pn = rem / nt; u.m = rem - u.pn * nt; u.e = e; u.nt = nt; u.pm = t0 + u.m; const int left = cnt - 256 * u.m; u.nv = left < 256 ? left : 256; return true;
    }
    __device__ __forceinline__ const char* b_base(const Unit& u) const { return Bt + (size_t)u.e * bexp + (size_t)u.pn * TSTEP; }
    __device__ __forceinline__ void meta_issue(const Unit& u, LAS unsigned char* eb, LAS unsigned char* cb, int wid, int lane) const {
        if (wid < 4) __builtin_amdgcn_global_load_lds((const unsigned*)(list + (size_t)u.e * LCAP + 256 * u.m + 64 * wid + lane), (LAS unsigned*)(eb + wid * 1024), 16, 0, 0);
        else if (wid == 4) __builtin_amdgcn_global_load_lds((const unsigned*)(cbase + (size_t)u.e * cexp + u.pn * 256 + 4 * lane), (LAS unsigned*)cb, 16, 0, 0);
    }
};
template <int KB> struct MoeGatherT : MoeOrderT<KB> {
    static constexpr bool DEP = false;
    using MoeOrderT<KB>::A;
    __device__ __forceinline__ const char* a_base(const Unit&) const { return A; }
    __device__ __forceinline__ void a_off(const Unit& u, unsigned (&v)[2][2], int tid, const LAS unsigned char* eb) const {
        int R[2], C[2]; stage_rc(tid * 16, R[0], C[0]); stage_rc(tid * 16 + 8192, R[1], C[1]);
#pragma unroll
        for (int h = 0; h < 2; ++h)
#pragma unroll
            for (int i = 0; i < 2; ++i) { const int pos = 128 * h + R[i]; unsigned ts = *(const LAS unsigned*)(eb + pos * 16); ts = pos < u.nv ? ts : 0u;
                v[h][i] = (ts >> 2) * (unsigned)KB + (unsigned)C[i] * 2u; }
    }
};
template <int KB> struct MoeDenseT : MoeOrderT<KB> {
    static constexpr bool DEP = true;
    int dep_from; unsigned dep_target; unsigned* dep_ctr; unsigned* dep_tmo;
    __device__ __forceinline__ bool dep(const Unit& u) const { return 16 * (u.pm - u.m) + 15 * u.nt + u.m >= dep_from; }
    __device__ __forceinline__ void dep_wait() const {
        unsigned sp = 0u;
        while (__hip_atomic_load(dep_ctr, __ATOMIC_RELAXED, __HIP_MEMORY_SCOPE_AGENT) < dep_target) { __builtin_amdgcn_s_sleep(1); if (++sp > (1u << 20)) { atomicAdd(dep_tmo, 1u); break; } }
        __builtin_amdgcn_fence(__ATOMIC_ACQUIRE, "agent");
        asm volatile("s_waitcnt vmcnt(0)" ::: "memory");
    }
    using MoeOrderT<KB>::A; using MoeOrderT<KB>::HSTEP; using MoeOrderT<KB>::TSTEP;
    __device__ __forceinline__ const char* a_base(const Unit& u) const { return A + (size_t)u.pm * TSTEP; }
    __device__ __forceinline__ void a_off(const Unit&, unsigned (&v)[2][2], int tid, const LAS unsigned char*) const {
        int R[2], C[2]; stage_rc(tid * 16, R[0], C[0]); stage_rc(tid * 16 + 8192, R[1], C[1]);
#pragma unroll
        for (int h = 0; h < 2; ++h)
#pragma unroll
            for (int i = 0; i < 2; ++i) v[h][i] = (unsigned)(h * (int)HSTEP) + (unsigned)(R[i] * KB + C[i] * 2);
    }
};

template <class Epi, class Sched, bool FP8>
__device__ __forceinline__ void gemm_phase(LAS unsigned char* lds, LAS unsigned char* meta, const Sched& S, const Epi& E, int krep = 1) {
    constexpr int KB = FP8 ? KB8 : KB16, NT = KB / 128;
    constexpr size_t HSTEP = (size_t)HALF * KB;
    const int tid = threadIdx.x, wid = __builtin_amdgcn_readfirstlane(tid >> 6), lane = tid & 63, wr = wid >> 2, wc = wid & 3, fr = lane & 15, fq = lane >> 4;
#ifdef PROBE_KREP
    const bool PG8_PROBE_NOSTAGE = (krep & 32) != 0, PG8_PROBE_NOMMA = (krep & 64) != 0, PG8_PROBE_NOEPI = (krep & 128) != 0; krep &= 15;
#else
    constexpr bool PG8_PROBE_NOSTAGE = false, PG8_PROBE_NOMMA = false, PG8_PROBE_NOEPI = false;
#endif
    unsigned voffB[2];
#pragma unroll
    for (int i = 0; i < 2; ++i) { int R, C; stage_rc(tid * 16 + i * 8192, R, C); const int Rb = Epi::PERM ? ((R & ~31) + perm32(R & 31)) : R;
        voffB[i] = (unsigned)(Rb * KB + C * 2); }
    const size_t kstep = KSTEP, hstep = HSTEP;
    const unsigned ldsw = (unsigned)wid * 1024u;
    const int aoff = lds_byte(wr * 64 + fr, fq * 8), boff = lds_byte(wc * 32 + fr, fq * 8);
#define PG8_SA(b, h) (((b) * 2 + (h)) * HTB)
#define PG8_SB(b, h) ((4 + (b) * 2 + (h)) * HTB)
#define PG8_STAGE(bufoff, gbase, voff) do { if (PG8_PROBE_NOSTAGE) break; _Pragma("unroll") for (int _i = 0; _i < 2; ++_i) \
        __builtin_amdgcn_global_load_lds((const unsigned*)((const char*)(gbase) + (voff)[_i]), (LAS unsigned*)(lds + (bufoff) + ldsw + _i * 8192), 16, 0, 0); } while (0)
#define PG8_LDA(dst, b, h) do { _Pragma("unroll") for (int m = 0; m < 4; ++m) { if constexpr (FP8) { dst##8[m].lo = *(const LAS i32x4*)(lds + PG8_SA(b, h) + aoff + m * 2048); dst##8[m].hi = *(const LAS i32x4*)(lds + PG8_SA(b, h) + aoff + m * 2048 + 1024); } \
        else { _Pragma("unroll") for (int k = 0; k < 2; ++k) dst[m][k] = *(const LAS bf16x8*)(lds + PG8_SA(b, h) + aoff + m * 2048 + k * 1024); } } } while (0)
#define PG8_LDB(dst, b, h) do { _Pragma("unroll") for (int n = 0; n < 2; ++n) { if constexpr (FP8) { dst##8[n].lo = *(const LAS i32x4*)(lds + PG8_SB(b, h) + boff + n * 2048); dst##8[n].hi = *(const LAS i32x4*)(lds + PG8_SB(b, h) + boff + n * 2048 + 1024); } \
        else { _Pragma("unroll") for (int k = 0; k < 2; ++k) dst[n][k] = *(const LAS bf16x8*)(lds + PG8_SB(b, h) + boff + n * 2048 + k * 1024); } } } while (0)
#define PG8_MMA(ai, bj, At, Bt) do { if (PG8_PROBE_NOMMA) break; __builtin_amdgcn_s_setprio(1); _Pragma("unroll") for (int m = 0; m < 4; ++m) _Pragma("unroll") for (int n = 0; n < 2; ++n) { \
        if constexpr (FP8) asm volatile("v_mfma_scale_f32_16x16x128_f8f6f4 %0, %1, %2, %0, %3, %4 op_sel_hi:[0,0,0]" : "+v"(acc[ai][bj][m][n]) : "v"(Bt##8[n]), "v"(At##8[m]), "v"(sclw), "v"(scl1)); \
        else { _Pragma("unroll") for (int k = 0; k < 2; ++k) acc[ai][bj][m][n] = __builtin_amdgcn_mfma_f32_16x16x32_bf16(Bt[n][k], At[m][k], acc[ai][bj][m][n], 0, 0, 0); } } \
        __builtin_amdgcn_s_setprio(0); } while (0)
#define PG8_WAIT_V(n) asm volatile("s_waitcnt vmcnt(" #n ")" ::: "memory")
#define PG8_WAIT_L(n) asm volatile("s_waitcnt lgkmcnt(" #n ")" ::: "memory")
#define PG8_BAR __builtin_amdgcn_s_barrier()
#define PG8_SCHED __builtin_amdgcn_sched_barrier(0)
    Unit cur, nxt; int ui = 0;
    if (!S.next(0, cur)) return;
    nxt = cur;
    f32x4 acc[2][2][4][2];
#pragma unroll
    for (int a = 0; a < 2; ++a)
#pragma unroll
        for (int b = 0; b < 2; ++b)
#pragma unroll
            for (int m = 0; m < 4; ++m)
#pragma unroll
                for (int n = 0; n < 2; ++n) acc[a][b][m][n] = (f32x4){0.f, 0.f, 0.f, 0.f};
    bf16x8 At[4][2], B0[2][2], B1[2][2]; i32x8 At8[4], B08[2], B18[2];
    unsigned cv[2][2], nv[2][2];
    int sclw = 0, scl1 = 0;
    if constexpr (FP8) { asm volatile("v_mov_b32 %0, %2\n\tv_mov_b32 %1, %3" : "=v"(sclw), "=v"(scl1) : "s"(W8_SCALE_E8), "s"(0x7F7F7F7F)); }
#define PG8_EB(par) (meta + (par) * 4096)
#define PG8_CB(par) (meta + 8192 + (par) * 1024)
    if constexpr (Sched::DEP) { if (S.dep(cur)) { if (wid == 7) S.dep_wait(); } }
    if constexpr (Sched::META) { S.meta_issue(cur, PG8_EB(0), PG8_CB(0), wid, lane); PG8_WAIT_V(0); PG8_BAR; }
    S.a_off(cur, cv, tid, PG8_EB(0));
#pragma unroll
    for (int h = 0; h < 2; ++h)
#pragma unroll
        for (int i = 0; i < 2; ++i) nv[h][i] = cv[h][i];
    const char* cA = S.a_base(cur); const char* cB = S.b_base(cur);
    PG8_STAGE(PG8_SB(0, 0), cB, voffB); PG8_STAGE(PG8_SB(0, 1), cB + hstep, voffB); PG8_STAGE(PG8_SA(0, 0), cA, cv[0]); PG8_STAGE(PG8_SA(0, 1), cA, cv[1]);
    if (wr == 1) PG8_BAR;
    PG8_WAIT_V(2); PG8_BAR;
    PG8_STAGE(PG8_SB(1, 0), cB + kstep, voffB); PG8_STAGE(PG8_SA(1, 0), cA + kstep, cv[0]); PG8_STAGE(PG8_SB(1, 1), cB + hstep + kstep, voffB);
    PG8_WAIT_V(6); PG8_BAR;
    for (;;) {
        const bool has_next = S.next(ui + 1, nxt);
        const char* nA = has_next ? S.a_base(nxt) : cA; const char* nB = has_next ? S.b_base(nxt) : cB;
#ifdef PROBE_KREP
        const int ntk = NT * krep;
#else
        constexpr int ntk = NT;
#endif
#pragma unroll 1
        for (int tt = 0; tt < ntk; tt += 2) {
            const int t = tt & (NT - 1);
            const bool last = (tt == ntk - 2);
            const char* a1 = cA + (size_t)(t + 1) * kstep;
            if (last && has_next) S.a_off(nxt, nv, tid, PG8_EB((ui + 1) & 1));
            const char* a2 = last ? nA : cA + (size_t)(t + 2) * kstep; const char* b2 = last ? nB : cB + (size_t)(t + 2) * kstep;
            const char* a3 = a2 + kstep; const char* b3 = b2 + kstep;
            unsigned s2[2][2];
#pragma unroll
            for (int h = 0; h < 2; ++h)
#pragma unroll
                for (int i = 0; i < 2; ++i) s2[h][i] = last ? nv[h][i] : cv[h][i];
            PG8_LDB(B0, 0, 0); PG8_LDB(B1, 0, 1); PG8_SCHED; PG8_LDA(At, 0, 0); PG8_STAGE(PG8_SA(1, 1), a1, cv[1]);
            PG8_WAIT_V(8); PG8_WAIT_L(0); PG8_BAR; PG8_MMA(0, 0, At, B0); PG8_MMA(0, 1, At, B1); PG8_BAR; PG8_SCHED;
            if constexpr (Sched::DEP) { if (tt == 0 && has_next && S.dep(nxt)) { if (wid == 7) S.dep_wait(); } }
            if constexpr (Sched::META) { if (tt == 0 && has_next) S.meta_issue(nxt, PG8_EB((ui + 1) & 1), PG8_CB((ui + 1) & 1), wid, lane); }
            PG8_LDA(At, 0, 1); PG8_STAGE(PG8_SB(0, 0), b2, voffB); PG8_STAGE(PG8_SB(0, 1), b2 + hstep, voffB); PG8_STAGE(PG8_SA(0, 0), a2, s2[0]);
            PG8_WAIT_V(8); PG8_WAIT_L(0); PG8_BAR; PG8_MMA(1, 0, At, B0); PG8_MMA(1, 1, At, B1); PG8_BAR; PG8_SCHED;
            PG8_LDB(B0, 1, 0); PG8_LDB(B1, 1, 1); PG8_SCHED; PG8_LDA(At, 1, 0); PG8_STAGE(PG8_SA(0, 1), a2, s2[1]);
            PG8_WAIT_V(8); PG8_WAIT_L(0); PG8_BAR; PG8_MMA(0, 0, At, B0); PG8_MMA(0, 1, At, B1); PG8_BAR; PG8_SCHED;
            PG8_LDA(At, 1, 1); PG8_STAGE(PG8_SB(1, 0), b3, voffB); PG8_STAGE(PG8_SB(1, 1), b3 + hstep, voffB); PG8_STAGE(PG8_SA(1, 0), a3, s2[0]);
            PG8_WAIT_V(8); PG8_WAIT_L(0); PG8_BAR; PG8_MMA(1, 0, At, B0); PG8_MMA(1, 1, At, B1); PG8_BAR; PG8_SCHED;
        }
        if (wr == 0) PG8_BAR;
        if constexpr (FP8) asm volatile("s_nop 15\n\ts_nop 7" ::: "memory");
        if (!PG8_PROBE_NOEPI) E(acc, cur, wr, wc, fr, fq, PG8_EB(ui & 1), PG8_CB(ui & 1));
        if (!has_next) break;
#pragma unroll
        for (int a = 0; a < 2; ++a)
#pragma unroll
            for (int b = 0; b < 2; ++b)
#pragma unroll
                for (int m = 0; m < 4; ++m)
#pragma unroll
                    for (int n = 0; n < 2; ++n) acc[a][b][m][n] = (f32x4){0.f, 0.f, 0.f, 0.f};
        cur = nxt; cA = nA; cB = nB; ++ui;
#pragma unroll
        for (int h = 0; h < 2; ++h)
#pragma unroll
            for (int i = 0; i < 2; ++i) cv[h][i] = nv[h][i];
        if (wr == 1) PG8_BAR;
    }
    PG8_WAIT_V(0);
    PG8_BAR;
#undef PG8_EB
#undef PG8_CB
#undef PG8_SA
#undef PG8_SB
#undef PG8_STAGE
#undef PG8_LDA
#undef PG8_LDB
#undef PG8_MMA
#undef PG8_WAIT_V
#undef PG8_WAIT_L
#undef PG8_BAR
#undef PG8_SCHED
}
}

#define XB_TMO      128
#define XB_XCNT(j)  (256  + 64 * (j))
#define XB_XSUB(j)  (1280 + 64 * (j))
#define XB_XGEN(j)  (2304 + 64 * (j))
#define XB_TOP      3328
#define XB_TOPGEN   3392
#define XCD_BAR_WORDS 3456
#define XB_SPIN_CAP (1u << 18)
__device__ __forceinline__ unsigned xb_ld(unsigned* p)              { return __hip_atomic_load(p, __ATOMIC_RELAXED, __HIP_MEMORY_SCOPE_AGENT); }
__device__ __forceinline__ unsigned xb_add(unsigned* p, unsigned v) { return __hip_atomic_fetch_add(p, v, __ATOMIC_RELAXED, __HIP_MEMORY_SCOPE_AGENT); }
__device__ __forceinline__ unsigned xb_xcc_id() { return (unsigned)__builtin_amdgcn_s_getreg((3 << 11) | 20) & 0xFu; }
#define XB_SPIN(cond, bar) do { unsigned _sp = 0; while (cond) { __builtin_amdgcn_s_sleep(1); \
    if ((++_sp & 255u) == 0u) { if (xb_ld(&(bar)[XB_TMO])) break; if (_sp > XB_SPIN_CAP) { atomicAdd(&(bar)[XB_TMO], 1u); break; } } } } while (0)
struct XcdBarrier { unsigned* bar; unsigned x; volatile LAS unsigned* st; };
__device__ __forceinline__ XcdBarrier xcd_barrier_post(unsigned* bar, volatile LAS unsigned* st) {
    XcdBarrier b; b.bar = bar; b.x = xb_xcc_id(); b.st = st;
    if (threadIdx.x == 0) (void)xb_add(&bar[XB_XCNT(b.x)], 1u);
    return b;
}
__device__ __forceinline__ void xcd_barrier_complete(unsigned* bar, unsigned x, unsigned& nloc, unsigned& nx) {
    const unsigned G = gridDim.x * gridDim.y * gridDim.z;
    unsigned sum, cnt, mine, sp = 0u;
    for (;;) {
        sum = 0u; cnt = 0u; mine = 0u;
#pragma unroll
        for (unsigned j = 0; j < 16; ++j) { const unsigned c = xb_ld(&bar[XB_XCNT(j)]); sum += c; cnt += (c > 0u) ? 1u : 0u; mine = (j == x) ? c : mine; }
        if (sum == G) break;
        __builtin_amdgcn_s_sleep(1);
        if ((++sp & 255u) == 0u) { if (xb_ld(&bar[XB_TMO])) break; if (sp > XB_SPIN_CAP) { atomicAdd(&bar[XB_TMO], 1u); break; } }
    }
    nloc = mine > 0u ? mine : 1u; nx = cnt > 0u ? cnt : 1u;
}
__device__ __forceinline__ void xcd_barrier(const XcdBarrier& b) {
    asm volatile("s_waitcnt vmcnt(0)" ::: "memory");
    __syncthreads();
    if (threadIdx.x == 0) {
        unsigned* bar = b.bar;
        __builtin_amdgcn_s_waitcnt(0);
        unsigned nloc = b.st[0], nx = b.st[1];
        if (nloc == 0u) { xcd_barrier_complete(bar, b.x, nloc, nx); b.st[0] = nloc; b.st[1] = nx; }
        const unsigned old = xb_add(&bar[XB_XSUB(b.x)], 1u);
        const unsigned gen = old / nloc;
        if (old + 1u == (gen + 1u) * nloc) {
            __builtin_amdgcn_fence(__ATOMIC_RELEASE, "agent");
            asm volatile("s_waitcnt vmcnt(0)" ::: "memory");
            const unsigned og = xb_add(&bar[XB_TOP], 1u);
            const unsigned tg = og / nx;
            if (og + 1u == (tg + 1u) * nx) xb_add(&bar[XB_TOPGEN], 1u);
            else XB_SPIN(xb_ld(&bar[XB_TOPGEN]) == tg, bar);
            __builtin_amdgcn_fence(__ATOMIC_ACQUIRE, "agent");
            xb_add(&bar[XB_XGEN(b.x)], 1u);
            asm volatile("s_waitcnt vmcnt(0)" ::: "memory");
        } else {
            XB_SPIN(xb_ld(&bar[XB_XGEN(b.x)]) == gen, bar);
            __builtin_amdgcn_fence(__ATOMIC_ACQUIRE, "agent");
            asm volatile("s_waitcnt vmcnt(0)" ::: "memory");
        }
    }
    __syncthreads();
}

struct Args { const float* in[28]; float* out; unsigned char* ws; int ph_lo, ph_hi, krep, pad; };
struct Frame {
    LAS unsigned char* lds;
    const Args* a;
    int tid, lane, wave, vcu, G;
};
#define F_IN(i) (F.a->in[i])
#define F_x F_IN(0)
#define F_c F_IN(1)
#define F_w_ada F_IN(2)
#define F_b_ada F_IN(3)
#define F_g_norm1 F_IN(4)
#define F_w_in F_IN(5)
#define F_b_in F_IN(6)
#define F_g_q F_IN(7)
#define F_g_k F_IN(8)
#define F_sinks F_IN(9)
#define F_rel_bias F_IN(10)
#define F_w_dw F_IN(11)
#define F_b_dw F_IN(12)
#define F_ln_g F_IN(13)
#define F_ln_b F_IN(14)
#define F_g_out_attn F_IN(15)
#define F_g_out_conv F_IN(16)
#define F_w_out F_IN(17)
#define F_b_out F_IN(18)
#define F_g_norm2 F_IN(19)
#define F_w_router F_IN(20)
#define F_b_router F_IN(21)
#define F_w_gate F_IN(22)
#define F_b_gate F_IN(23)
#define F_w_up F_IN(24)
#define F_b_up F_IN(25)
#define F_w_down F_IN(26)
#define F_b_down F_IN(27)
#define F_out (F.a->out)
#define F_ws (F.a->ws)
#define F_ctl ((unsigned*)(F_ws + WS_CTL))
#define F_WinT ((bf16*)(F_ws + WS_WIN))
#define F_WoutT ((bf16*)(F_ws + WS_WOUT))
#define F_WguT ((unsigned char*)(F_ws + WS_WGU))
#define F_WdnT ((unsigned char*)(F_ws + WS_WDN))
#define F_h8 ((unsigned char*)(F_ws + WS_H8))
#define F_hb ((bf16*)(F_ws + WS_H))
#define F_qb ((bf16*)(F_ws + WS_Q))
#define F_kb ((bf16*)(F_ws + WS_K))
#define F_vb ((bf16*)(F_ws + WS_V))
#define F_glu ((bf16*)(F_ws + WS_GLU))
#define F_x1b ((bf16*)(F_ws + WS_H))
#define F_mix ((unsigned char*)(F_ws + WS_MIX))
#define F_act ((unsigned char*)(F_ws + WS_ACT))
#define F_part ((unsigned char*)(F_ws + WS_PART))
constexpr float PART_MUL = 8.0f;
#define F_modf ((float*)(F_ctl + CW_MOD))
#define F_modp ((float*)(F_ws + WS_MISC + MS_MODP))
#define F_cvr ((float*)(F_ctl + CW_CVR))
#define F_cvgu ((float*)(F_ctl + CW_CVGU))
#define F_biasp ((float*)(F_ws + WS_MISC + MS_BIASP))
#define F_ra ((float*)(F_ws + WS_MISC + MS_RA))
#define F_topw ((float*)(F_ws + WS_MISC + MS_TOPW))
#define F_wr2 ((float*)(F_ws + WS_MISC + MS_WR2))
#define F_list ((u32x4*)(F_ws + WS_LIST))
__device__ __forceinline__ float modv(const Frame& F, int i) { return F_modf[i]; }
__device__ __forceinline__ f32x4 modv4(const Frame& F, int i) { return *(const f32x4*)(F_modf + i); }

__device__ __forceinline__ void ph0_mod(Frame& F) {
    const int gw = F.vcu * 8 + F.wave, NGW = F.G * 8;
    for (int it = gw; it < 32 * 48; it += NGW) {
        const int kc = it / 48, ng = it % 48, k0 = kc * 64, n0 = ng * 256 + 4 * F.lane;
        const float cvv = F_c[k0 + F.lane]; const float sv = cvv / (1.f + __expf(-cvv));
        f32x4 a = (f32x4){0.f, 0.f, 0.f, 0.f};
#pragma unroll 16
        for (int kk = 0; kk < 64; ++kk) { const float s = __shfl(sv, kk); const f32x4 w = __builtin_nontemporal_load((const f32x4*)(F_w_ada + (size_t)(k0 + kk) * (6 * D) + n0)); a += s * w; }
        *(f32x4*)(F_modp + (size_t)kc * (6 * D) + n0) = a;
    }
}

__device__ __forceinline__ void ph0b_modsum(Frame& F) {
    const int gt = (F.vcu * 8 + F.wave) * 64 + F.lane;
    if (gt < 6 * D / 4) { f32x4 a = *(const f32x4*)(F_b_ada + 4 * gt);
#pragma unroll 8
        for (int kc = 0; kc < 32; ++kc) a += *(const f32x4*)(F_modp + (size_t)kc * (6 * D) + 4 * gt);
        *(f32x4*)(F_modf + 4 * gt) = a; }
}

template <bool CV, bool FP8W>
__device__ __forceinline__ void tr_item(const Frame& F, const float* W, int N, void* WTv, int c0, int k0, int n0, LAS float* scr, int lane, float* cvdst, const float* bias) {
#pragma unroll 8
    for (int i = 0; i < 32; ++i) { const int kk = 2 * i + (lane >> 5); scr[kk * 33 + (lane & 31)] = __builtin_nontemporal_load(W + (size_t)(k0 + kk) * N + n0 + (lane & 31)); }
    if (CV) scr[64 * 33 + lane] = modv(F, 3 * D + k0 + lane);
    LDS_WAIT(); asm volatile("" ::: "memory");
    const int c = lane & 7;
#pragma unroll
    for (int j = 0; j < 4; ++j) { const int n = (lane >> 3) + 8 * j; const LAS float* s = scr + (8 * c) * 33 + n;
        if (FP8W) { u32x2 o; o.x = pk4_fp8(s[0 * 33] * W8_MUL, s[1 * 33] * W8_MUL, s[2 * 33] * W8_MUL, s[3 * 33] * W8_MUL); o.y = pk4_fp8(s[4 * 33] * W8_MUL, s[5 * 33] * W8_MUL, s[6 * 33] * W8_MUL, s[7 * 33] * W8_MUL);
            *(u32x2*)((unsigned char*)WTv + (size_t)(c0 + n) * D + k0 + 8 * c) = o; }
        else { u32x4 o; o.x = cvt_pk_bf16(s[0 * 33], s[1 * 33]); o.y = cvt_pk_bf16(s[2 * 33], s[3 * 33]); o.z = cvt_pk_bf16(s[4 * 33], s[5 * 33]); o.w = cvt_pk_bf16(s[6 * 33], s[7 * 33]);
            *(u32x4*)((bf16*)WTv + (size_t)(c0 + n) * D + k0 + 8 * c) = o; } }
    if (CV) {
        const int n = lane & 31, hf = lane >> 5; float s = 0.f;
#pragma unroll 8
        for (int kk = 0; kk < 32; ++kk) s += scr[64 * 33 + 32 * hf + kk] * scr[(32 * hf + kk) * 33 + n];
        s += __shfl_xor(s, 32);
        if (lane < 32) { if (k0 == 0) s += bias[n0 + n]; atomicAdd(cvdst + c0 + n, s); }
    }
    LDS_WAIT(); asm volatile("" ::: "memory");
}
__device__ __forceinline__ int win_dst(int n0) {
    if (n0 < 1280) { const int pn = n0 >> 8, rem = n0 & 255, wc = rem >> 6, bj = (rem & 63) >> 5; return 256 * pn + 128 * bj + 32 * wc; }
    const int n1 = n0 - 1280, bj = n1 >> 10, n2 = n1 & 1023, j = n2 >> 7, wc = (n2 & 127) >> 5; return 256 * (5 + j) + 128 * bj + 32 * wc;
}
__device__ __forceinline__ int win_src(int c) {
    const int pn = c >> 8, bj = (c >> 7) & 1, wc = (c >> 5) & 3, i = c & 31;
    if (pn < 5) return 256 * pn + 64 * wc + 32 * bj + i;
    return 1280 + 1024 * bj + 128 * (pn - 5) + 32 * wc + i;
}
__device__ __forceinline__ int down_row(int sc) { return (sc & ~255) + 128 * ((sc >> 3) & 1) + 32 * ((sc >> 6) & 3) + 8 * ((sc >> 4) & 3) + (sc & 7); }
template <bool CV>
__device__ __forceinline__ void tr_moe_item(const float* W, unsigned char* WT, int c0, int n0, LAS float* scr, const LAS float* shl, int lane, float* cvdst, const float* bias, int probe = 0) {
    const int lr0 = lane >> 3, lc0 = lane & 7;
    const unsigned long long wbase = (unsigned long long)W;
    const unsigned wlo = __builtin_amdgcn_readfirstlane((unsigned)wbase), whi = __builtin_amdgcn_readfirstlane((unsigned)(wbase >> 32));
    const __amdgpu_buffer_rsrc_t rs = __builtin_amdgcn_make_buffer_rsrc((void*)(((unsigned long long)whi << 32) | wlo), 0, D * D * 4, 0x00020000);
    const unsigned loff = (unsigned)(lr0 * D + 4 * lc0 + n0) * 4u;
#define TR_LOAD(rowk) __builtin_bit_cast(f32x4, __builtin_amdgcn_raw_buffer_load_b128(rs, loff, (unsigned)(rowk) * (unsigned)(D * 4), 2))
#ifdef PROBE_KREP
    const int pr_rowmul = (probe & 256) ? 32 : D, pr_kmul = (probe & 256) ? 0 : 1;
#else
    constexpr int pr_rowmul = D, pr_kmul = 1;
#endif
    f32x4 pre[2][16];
#pragma unroll
    for (int q = 0; q < 2; ++q)
#pragma unroll
        for (int i = 0; i < 16; ++i) pre[q][i] = TR_LOAD(128 * q + 8 * i);
    f32x2 cvs[4] = {{0.f, 0.f}, {0.f, 0.f}, {0.f, 0.f}, {0.f, 0.f}};
#pragma unroll 1
    for (int kp2 = 0; kp2 < 16; kp2 += 2) {
#pragma unroll
        for (int q = 0; q < 2; ++q) {
            const int kp = kp2 + q, kn = kp + 2 < 16 ? kp + 2 : 15;
            int lc = lc0, lr = lr0; asm volatile("" : "+v"(lc), "+v"(lr));
#pragma unroll
            for (int i = 0; i < 16; ++i) *(LAS f32x4*)(scr + (8 * i + lr) * 32 + 4 * ((lc + (i >> 1)) & 7)) = pre[q][i];
#pragma unroll
            for (int i = 0; i < 16; ++i) pre[q][i] = TR_LOAD(128 * kn + 8 * i);
            LDS_WAIT(); asm volatile("" ::: "memory");
            f32x2 shv[8];
            if (CV) {
#pragma unroll
                for (int t = 0; t < 8; ++t) shv[t] = *(const LAS f32x2*)(shl + 128 * kp + 16 * lc + 2 * t);
            }
#pragma unroll
            for (int j = 0; j < 4; ++j) {
                const LAS float* col = scr + (16 * lc) * 32 + ((lr + 8 * j + 4 * lc) & 31);
                f32x2 pv[8];
#pragma unroll
                for (int t = 0; t < 8; ++t) { f32x2 r; r.x = col[(2 * t) * 32]; r.y = col[(2 * t + 1) * 32]; pv[t] = r * W8_MUL; }
                if (CV) {
#pragma unroll
                    for (int t = 0; t < 8; ++t) cvs[j] += shv[t] * pv[t];
                }
                u32x4 o;
                o.x = pk_hi_lo_fp8(pv[0], pv[1]); o.y = pk_hi_lo_fp8(pv[2], pv[3]); o.z = pk_hi_lo_fp8(pv[4], pv[5]); o.w = pk_hi_lo_fp8(pv[6], pv[7]);
                const unsigned roffj = (unsigned)((CV ? c0 + lr + 8 * j : down_row(n0 + lr + 8 * j)) * pr_rowmul + 16 * lc * pr_kmul);
                __builtin_nontemporal_store(o, (u32x4*)(WT + roffj + (size_t)(128 * kp) * pr_kmul));
            }
            LDS_WAIT(); asm volatile("" ::: "memory");
        }
    }
#undef TR_LOAD
    if (CV) {
#pragma unroll
        for (int j = 0; j < 4; ++j) { float t = (cvs[j].x + cvs[j].y) * (1.0f / W8_MUL); t += __shfl_xor(t, 1); t += __shfl_xor(t, 2); t += __shfl_xor(t, 4); if (lc0 == 0) cvdst[c0 + lr0 + 8 * j] = t + bias[n0 + lr0 + 8 * j]; }
    }
}
__device__ __forceinline__ void moe_convert(Frame& F, int gw, int NGW, int probe = 0) {
    LAS float* scr = (LAS float*)(F.lds + F.wave * 16384);
    LAS float* shl = (LAS float*)(F.lds + 8 * 16384);
    const int lane = F.lane;
    for (int i = F.tid; i < D; i += 512) shl[i] = modv(F, 3 * D + i);
    __syncthreads();
    for (int it = gw; it < 3 * NE * 64; it += NGW) {
        const int nb = it & 63, e = (it >> 6) & 31, mat = it >> 11, n0 = 32 * nb;
#ifdef PROBE_KREP
        if (probe & 512) continue;
#endif
        if (mat == 2) tr_moe_item<false>(F_w_down + (size_t)e * D * D, F_WdnT + (size_t)e * D * D, n0, n0, scr, shl, lane, nullptr, nullptr, probe);
        else tr_moe_item<true>((mat ? F_w_up : F_w_gate) + (size_t)e * D * D, F_WguT + (size_t)e * 2 * D * D, 256 * (n0 >> 7) + 128 * mat + (n0 & 127), n0, scr, shl, lane, F_cvgu + e * 4096, (mat ? F_b_up : F_b_gate) + e * D, probe);
    }
    __syncthreads();
}
__device__ __forceinline__ void ph1_prologue(Frame& F) {
    LAS float* scr = (LAS float*)(F.lds + F.wave * 16384);
    const int gw = F.vcu * 8 + F.wave, NGW = F.G * 8, lane = F.lane;
    constexpr int I_IN = 32 * (DIN / 32), I_OUT = 32 * (D / 32);
    for (int it = gw; it < I_IN + I_OUT; it += NGW) {
        int r = it;
        if (r < I_IN) { const int nb = r % (DIN / 32), kb = r / (DIN / 32); tr_item<false, false>(F, F_w_in, DIN, F_WinT, win_dst(32 * nb), 64 * kb, 32 * nb, scr, lane, nullptr, nullptr); continue; } r -= I_IN;
        { const int nb = r % 64, kb = r / 64; tr_item<false, true>(F, F_w_out, D, F_WoutT, 32 * nb, 64 * kb, 32 * nb, scr, lane, nullptr, nullptr); }
    }
    {
        f32x4 ga[8], sh[8];
#pragma unroll
        for (int j = 0; j < 8; ++j) { const int cidx = 4 * lane + 256 * j; ga[j] = *(const f32x4*)(F_g_norm1 + cidx) * (modv4(F, D + cidx) + 1.0f); sh[j] = modv4(F, cidx); }
        for (int m = gw; m < T; m += NGW) {
            const f32x4* xr = (const f32x4*)(F_x + (size_t)m * D) + lane; f32x4 v[8]; float s = 0.f;
#pragma unroll
            for (int j = 0; j < 8; ++j) { v[j] = __builtin_nontemporal_load(xr + 64 * j); s += (v[j].x * v[j].x + v[j].y * v[j].y) + (v[j].z * v[j].z + v[j].w * v[j].w); }
            const float rn = __builtin_amdgcn_rsqf(wave_sum(s) * (1.f / D) + EPS);
            u32x2* o = (u32x2*)(F_hb + (size_t)m * D) + lane;
#pragma unroll
            for (int j = 0; j < 8; ++j) { const f32x4 y = v[j] * rn * ga[j] + sh[j]; u32x2 w; w.x = cvt_pk_bf16(y.x, y.y); w.y = cvt_pk_bf16(y.z, y.w); o[64 * j] = w; }
        }
    }
    const int gt = (F.vcu * 8 + F.wave) * 64 + lane, NGT = NGW * 64;
    for (int i = gt; i < DIN; i += NGT) F_biasp[i] = F_b_in[win_src(i)];
    for (int i = gt; i < D * NE; i += NGT) { const int k = i >> 5; F_wr2[i] = F_g_norm2[k] * (1.f + modv(F, 4 * D + k)) * F_w_router[i]; }
    if (gw < NE) { float s = 0.f; for (int k = lane; k < D; k += 64) s += modv(F, 3 * D + k) * F_w_router[k * NE + gw]; s = wave_sum(s); if (lane == 0) F_cvr[gw] = s + F_b_router[gw]; }
}

struct EpiInProj {
    static constexpr bool PERM = true;
    bf16 *q, *k, *v, *glu; const float *biasp, *gq, *gk;
    __device__ __forceinline__ void operator()(const f32x4 (&acc)[2][2][4][2], const pg8::Unit& u, int wr, int wc, int fr, int fq, const LAS unsigned char* eb, const LAS unsigned char* cbuf) const {
        asm volatile("" : "+v"(fr), "+v"(fq));
        const int row0 = u.pm * 256 + wr * 64 + fr, cb = u.pn * 256 + wc * 32 + 8 * fq;
        f32x4 bv[2][2];
#pragma unroll
        for (int bj = 0; bj < 2; ++bj)
#pragma unroll
            for (int n = 0; n < 2; ++n) bv[bj][n] = *(const f32x4*)(biasp + cb + 128 * bj + 4 * n);
        if (u.pn < 5) {
            const bool isq = u.pn < 4, isk = (u.pn == 4) && (wc < 2), nrm = isq || isk;
            bf16* base = isq ? q : (isk ? k : v); const int ld = isq ? DA : DKV; const int hcol = isq ? (4 * u.pn + wc) * 64 : (isk ? wc * 64 : (wc - 2) * 64);
            const float* gp = isq ? gq : gk; const float sc = isq ? QSCALE : 1.0f;
            f32x4 gv[2][2];
#pragma unroll
            for (int bj = 0; bj < 2; ++bj)
#pragma unroll
                for (int n = 0; n < 2; ++n) gv[bj][n] = nrm ? *(const f32x4*)(gp + 32 * bj + 8 * fq + 4 * n) * sc : (f32x4){1.f, 1.f, 1.f, 1.f};
#pragma unroll
            for (int ai = 0; ai < 2; ++ai)
#pragma unroll
                for (int m = 0; m < 4; ++m) {
                    f32x4 xv[2][2]; float ss = 0.f;
#pragma unroll
                    for (int bj = 0; bj < 2; ++bj)
#pragma unroll
                        for (int n = 0; n < 2; ++n) { xv[bj][n] = acc[ai][bj][m][n] + bv[bj][n]; const f32x4 t = xv[bj][n]; ss += (t.x * t.x + t.y * t.y) + (t.z * t.z + t.w * t.w); }
                    ss += __shfl_xor(ss, 16); ss += __shfl_xor(ss, 32);
                    const float rn = nrm ? __builtin_amdgcn_rsqf(ss * (1.f / 64.f) + EPS) : 1.0f;
                    bf16* rowp = base + (size_t)(row0 + 128 * ai + 16 * m) * ld + hcol + 8 * fq;
#pragma unroll
                    for (int bj = 0; bj < 2; ++bj) { const f32x4 a = xv[bj][0] * rn * gv[bj][0], b = xv[bj][1] * rn * gv[bj][1];
                        u32x4 w; w.x = cvt_pk_bf16(a.x, a.y); w.y = cvt_pk_bf16(a.z, a.w); w.z = cvt_pk_bf16(b.x, b.y); w.w = cvt_pk_bf16(b.z, b.w);
                        *(u32x4*)(rowp + 32 * bj) = w; }
                }
        } else {
            const int ccol = 128 * (u.pn - 5) + 32 * wc + 8 * fq;
#pragma unroll
            for (int ai = 0; ai < 2; ++ai)
#pragma unroll
                for (int m = 0; m < 4; ++m) {
                    float o[8];
#pragma unroll
                    for (int n = 0; n < 2; ++n) { const f32x4 a = acc[ai][0][m][n] + bv[0][n], g = acc[ai][1][m][n] + bv[1][n];
#pragma unroll
                        for (int j = 0; j < 4; ++j) o[4 * n + j] = a[j] * __builtin_amdgcn_rcpf(1.f + __builtin_amdgcn_exp2f(-LOG2E * g[j])); }
                    u32x4 w; w.x = cvt_pk_bf16(o[0], o[1]); w.y = cvt_pk_bf16(o[2], o[3]); w.z = cvt_pk_bf16(o[4], o[5]); w.w = cvt_pk_bf16(o[6], o[7]);
                    *(u32x4*)(glu + (size_t)(row0 + 128 * ai + 16 * m) * DC + ccol) = w;
                }
        }
    }
};
struct EpiOut {
    static constexpr bool PERM = false;
    const float *x, *ra, *modf, *b_out; bf16* out;
    __device__ __forceinline__ void operator()(const f32x4 (&acc)[2][2][4][2], const pg8::Unit& u, int wr, int wc, int fr, int fq, const LAS unsigned char* eb, const LAS unsigned char* cbuf) const {
        asm volatile("" : "+v"(fr), "+v"(fq));
        const int row0 = u.pm * 256 + wr * 64 + fr, col0 = u.pn * 256 + wc * 32 + 4 * fq;
        f32x4 g1[2][2], bo[2][2];
#pragma unroll
        for (int bj = 0; bj < 2; ++bj)
#pragma unroll
            for (int n = 0; n < 2; ++n) { const int c = col0 + 128 * bj + 16 * n; g1[bj][n] = *(const f32x4*)(modf + 2 * D + c); bo[bj][n] = *(const f32x4*)(b_out + c); }
#pragma unroll
        for (int ai = 0; ai < 2; ++ai)
#pragma unroll
            for (int mp = 0; mp < 2; ++mp) {
                f32x4 xv[2][2][2]; float rs[2];
#pragma unroll
                for (int mm = 0; mm < 2; ++mm) { const int r = row0 + 128 * ai + 16 * (2 * mp + mm); rs[mm] = ra[r]; const size_t off = (size_t)r * D + col0;
#pragma unroll
                    for (int bj = 0; bj < 2; ++bj)
#pragma unroll
                        for (int n = 0; n < 2; ++n) xv[mm][bj][n] = __builtin_nontemporal_load((const f32x4*)(x + off + 128 * bj + 16 * n)); }
#pragma unroll
                for (int mm = 0; mm < 2; ++mm) { const int m = 2 * mp + mm; const size_t off = (size_t)(row0 + 128 * ai + 16 * m) * D + col0;
#pragma unroll
                    for (int bj = 0; bj < 2; ++bj)
#pragma unroll
                        for (int n = 0; n < 2; ++n) { const f32x4 v = xv[mm][bj][n] + g1[bj][n] * (acc[ai][bj][m][n] * rs[mm] + bo[bj][n]); u32x2 w; w.x = cvt_pk_bf16(v.x, v.y); w.y = cvt_pk_bf16(v.z, v.w);
                            *(u32x2*)(out + off + 128 * bj + 16 * n) = w; } }
                asm volatile("" ::: "memory");
            }
    }
};
struct EpiGU {
    static constexpr bool PERM = true;
    unsigned char* act;
    __device__ __forceinline__ void operator()(const f32x4 (&acc)[2][2][4][2], const pg8::Unit& u, int wr, int wc, int fr, int fq, const LAS unsigned char* eb, const LAS unsigned char* cbuf) const {
        asm volatile("" : "+v"(fr), "+v"(fq));
        const int lrow0 = wr * 64 + fr; const LAS float* cvp = (const LAS float*)cbuf + wc * 32 + 8 * fq;
        f32x4 cg[2], cu[2];
#pragma unroll
        for (int n = 0; n < 2; ++n) { cg[n] = *(const LAS f32x4*)(cvp + 4 * n); cu[n] = *(const LAS f32x4*)(cvp + 128 + 4 * n); }
        float rsv[2][4];
#pragma unroll
        for (int ai = 0; ai < 2; ++ai)
#pragma unroll
            for (int m = 0; m < 4; ++m) rsv[ai][m] = *(const LAS float*)(eb + (lrow0 + 128 * ai + 16 * m) * 16 + 4);
#pragma unroll
        for (int ai = 0; ai < 2; ++ai)
#pragma unroll
            for (int m = 0; m < 4; ++m) { const int lr = lrow0 + 128 * ai + 16 * m; const float rs = lr < u.nv ? rsv[ai][m] : 0.f;
                float o[8];
#pragma unroll
                for (int n = 0; n < 2; ++n) { const f32x4 g = acc[ai][0][m][n] * rs + cg[n], l = acc[ai][1][m][n] * rs + cu[n];
#pragma unroll
                    for (int j = 0; j < 4; ++j) { const float gg = fminf(g[j], 7.0f), ll = fminf(fmaxf(l[j], -7.0f), 7.0f);
                        o[4 * n + j] = gg * __builtin_amdgcn_rcpf(1.f + __builtin_amdgcn_exp2f(-1.702f * LOG2E * gg)) * (ll + 1.0f); } }
                u32x2 w; w.x = pk4_fp8(o[0], o[1], o[2], o[3]); w.y = pk4_fp8(o[4], o[5], o[6], o[7]);
                *(u32x2*)(act + (size_t)(u.pm * 256 + lr) * D + 128 * u.pn + 32 * wc + 8 * fq) = w; }
    }
};
struct EpiDown {
    static constexpr bool PERM = true;
    unsigned char* part;
    __device__ __forceinline__ void operator()(const f32x4 (&acc)[2][2][4][2], const pg8::Unit& u, int wr, int wc, int fr, int fq, const LAS unsigned char* eb, const LAS unsigned char* cbuf) const {
        asm volatile("" : "+v"(fr), "+v"(fq));
        const int lrow0 = wr * 64 + fr, col0 = u.pn * 256 + wc * 64 + 16 * fq;
        f32x4 bd[2][2];
#pragma unroll
        for (int bj = 0; bj < 2; ++bj)
#pragma unroll
            for (int n = 0; n < 2; ++n) bd[bj][n] = *(const LAS f32x4*)((const LAS float*)cbuf + wc * 64 + 16 * fq + 8 * bj + 4 * n);
        unsigned tsv[2][4]; float wsv[2][4];
#pragma unroll
        for (int ai = 0; ai < 2; ++ai)
#pragma unroll
            for (int m = 0; m < 4; ++m) { const u32x2 en = *(const LAS u32x2*)(eb + (lrow0 + 128 * ai + 16 * m) * 16); const unsigned wb = *(const LAS unsigned*)(eb + (lrow0 + 128 * ai + 16 * m) * 16 + 8); tsv[ai][m] = en.x; wsv[ai][m] = __uint_as_float(wb); }
#pragma unroll
        for (int ai = 0; ai < 2; ++ai)
#pragma unroll
            for (int m = 0; m < 4; ++m) { const int lr = lrow0 + 128 * ai + 16 * m;
                if (lr < u.nv) { const unsigned ts = tsv[ai][m]; const float w8 = wsv[ai][m] * PART_MUL;
                    const f32x4 a = (acc[ai][0][m][0] + bd[0][0]) * w8, b = (acc[ai][0][m][1] + bd[0][1]) * w8, c = (acc[ai][1][m][0] + bd[1][0]) * w8, d = (acc[ai][1][m][1] + bd[1][1]) * w8;
                    u32x4 w; w.x = pk4_fp8(a.x, a.y, a.z, a.w); w.y = pk4_fp8(b.x, b.y, b.z, b.w); w.z = pk4_fp8(c.x, c.y, c.z, c.w); w.w = pk4_fp8(d.x, d.y, d.z, d.w);
                    *(u32x4*)(part + ((size_t)(ts & 3) * T + (ts >> 2)) * D + col0) = w; } }
    }
};

template <int I> struct ConvStep {
    static __device__ __forceinline__ void run(f32x2 (&o)[32], const f32x2 (&wv)[31], const bf16* glu, int rb, int c0) {
        const int row = rb - 30 + I; const int rc = row < 0 ? 0 : row; unsigned v = *(const unsigned*)(glu + (size_t)rc * DC + c0); v = row < 0 ? 0u : v;
        f32x2 xv; xv.x = bf_lo(v); xv.y = bf_hi(v);
#pragma unroll
        for (int j = 0; j < 31; ++j) { const int r = I - j; if (r >= 0 && r < 32) o[r] += wv[j] * xv; }
        ConvStep<I + 1>::run(o, wv, glu, rb, c0);
    }
};
template <> struct ConvStep<62> { static __device__ __forceinline__ void run(f32x2 (&)[32], const f32x2 (&)[31], const bf16*, int, int) {} };
__device__ __forceinline__ s16x4 vtr(const LAS unsigned char* p) { typedef short v4i16_t __attribute__((ext_vector_type(4))); return __builtin_bit_cast(s16x4, __builtin_amdgcn_ds_read_tr16_b64_v4i16((LAS v4i16_t*)p)); }
__device__ __forceinline__ void ph3_unit(Frame& F, int u, int probe = 0) {
    LAS unsigned char* L = F.lds;
    LAS unsigned char* Kl = L + P3_K; LAS unsigned char* Vl = L + P3_V; LAS float* tab = (LAS float*)(L + P3_TAB);
    LAS float* SSQ = (LAS float*)(L + P3_SSQ); LAS float* RA = (LAS float*)(L + P3_RA);
    const int tid = F.tid, lane = F.lane, w = F.wave, i16 = lane & 15, g4 = lane >> 4;
    const int q0 = u * 64, kbase = q0 - 128;
    for (int idx = tid; idx < 3072; idx += 512) { const int row = idx >> 4, ch = idx & 15, key = kbase + row; u32x4 kv = (u32x4){0u, 0u, 0u, 0u}, vv = kv;
        if (key >= 0) { kv = *(const u32x4*)(F_kb + (size_t)key * DKV + ch * 8); vv = *(const u32x4*)(F_vb + (size_t)key * DKV + ch * 8); }
        *(LAS u32x4*)(Kl + row * 288 + ch * 16) = kv; *(LAS u32x4*)(Vl + row * 288 + ch * 16) = vv; }
    for (int idx = tid; idx < 2048; idx += 512) { const int h = idx >> 7, d = idx & 127; int b = d;
        if (d >= 16) { b = 16 + (int)(logf((float)d * (1.f / 16.f)) / 2.0794415416798357f * 16.f); b = b > 31 ? 31 : b; }
        tab[idx] = F_rel_bias[b * NH + h] * LOG2E; }
    __syncthreads();
    bf16x8 nq0 = *(const bf16x8*)(F_qb + (size_t)(q0 + i16) * DA + w * 64 + 8 * g4), nq1 = *(const bf16x8*)(F_qb + (size_t)(q0 + i16) * DA + w * 64 + 32 + 8 * g4);
#pragma unroll 1
    for (int it = 0; it < 8; ++it) {
#ifdef PROBE_KREP
        if (probe & 256) break;
#endif
        const int hh = it >> 2, c = it & 3, h = w + 8 * hh; const float sink2 = F_sinks[h] * LOG2E;
        {
            const int t0 = c > 0 ? c - 1 : 0, qrow = q0 + 16 * c + i16;
            const bf16x8 qf0 = nq0, qf1 = nq1;
            { const int itn = it < 7 ? it + 1 : 7, hn = w + 8 * (itn >> 2), qn = q0 + 16 * (itn & 3) + i16;
              nq0 = *(const bf16x8*)(F_qb + (size_t)qn * DA + hn * 64 + 8 * g4); nq1 = *(const bf16x8*)(F_qb + (size_t)qn * DA + hn * 64 + 32 + 8 * g4); }
            f32x4 ga[4];
#pragma unroll
            for (int dt = 0; dt < 4; ++dt) ga[dt] = *(const f32x4*)(F_g_out_attn + h * 64 + 16 * dt + 4 * g4);
            f32x4 s[10];
#pragma unroll
            for (int tt = 0; tt < 10; ++tt) { const LAS unsigned char* kp = Kl + (16 * (t0 + tt) + i16) * 288 + (hh * 64 + 8 * g4) * 2;
                const bf16x8 k0 = *(const LAS bf16x8*)kp, k1 = *(const LAS bf16x8*)(kp + 64); f32x4 a = (f32x4){0.f, 0.f, 0.f, 0.f};
                a = __builtin_amdgcn_mfma_f32_16x16x32_bf16(k0, qf0, a, 0, 0, 0); a = __builtin_amdgcn_mfma_f32_16x16x32_bf16(k1, qf1, a, 0, 0, 0); s[tt] = a; }
            float mx = -1e30f;
#pragma unroll
            for (int tt = 0; tt < 10; ++tt)
#pragma unroll
                for (int r = 0; r < 4; ++r) { const int kk = 16 * (t0 + tt) + 4 * g4 + r, dist = 128 + 16 * c + i16 - kk; const bool valid = (dist >= 0) && (dist < 128) && (kbase + kk >= 0);
                    const float bb = tab[h * 128 + (valid ? dist : 0)]; const float sv = valid ? s[tt][r] + bb : -1e30f; s[tt][r] = sv; mx = fmaxf(mx, sv); }
            mx = fmaxf(mx, __shfl_xor(mx, 16)); mx = fmaxf(mx, __shfl_xor(mx, 32)); mx = fmaxf(mx, sink2);
            float l = 0.f;
#pragma unroll
            for (int tt = 0; tt < 10; ++tt)
#pragma unroll
                for (int r = 0; r < 4; ++r) { const float p = __builtin_amdgcn_exp2f(s[tt][r] - mx); s[tt][r] = p; l += p; }
            l += __shfl_xor(l, 16); l += __shfl_xor(l, 32);
            const float inv = 1.0f / (l + __builtin_amdgcn_exp2f(sink2 - mx));
            bf16x8 pf[5];
#pragma unroll
            for (int ks = 0; ks < 5; ++ks) { u32x4 w; w.x = cvt_pk_bf16(s[2 * ks][0], s[2 * ks][1]); w.y = cvt_pk_bf16(s[2 * ks][2], s[2 * ks][3]); w.z = cvt_pk_bf16(s[2 * ks + 1][0], s[2 * ks + 1][1]); w.w = cvt_pk_bf16(s[2 * ks + 1][2], s[2 * ks + 1][3]);
                pf[ks] = __builtin_bit_cast(bf16x8, w); }
            float ssq = 0.f;
#pragma unroll
            for (int dt = 0; dt < 4; ++dt) { f32x4 o = (f32x4){0.f, 0.f, 0.f, 0.f};
#pragma unroll
                for (int ks = 0; ks < 5; ++ks) { const LAS unsigned char* vp = Vl + (16 * (t0 + 2 * ks) + 4 * g4 + (i16 >> 2)) * 288 + (hh * 64 + 16 * dt + 4 * (i16 & 3)) * 2;
                    const s16x4 lo = vtr(vp), hi = vtr(vp + 16 * 288); bf16x8 vf; vf[0] = lo[0]; vf[1] = lo[1]; vf[2] = lo[2]; vf[3] = lo[3]; vf[4] = hi[0]; vf[5] = hi[1]; vf[6] = hi[2]; vf[7] = hi[3];
                    o = __builtin_amdgcn_mfma_f32_16x16x32_bf16(vf, pf[ks], o, 0, 0, 0); }
                o = o * inv; ssq += (o.x * o.x + o.y * o.y) + (o.z * o.z + o.w * o.w); o = o * ga[dt];
                *(unsigned*)(F_mix + (size_t)qrow * D + h * 64 + 16 * dt + 4 * g4) = pk4_fp8(o.x, o.y, o.z, o.w); }
            ssq += __shfl_xor(ssq, 16); ssq += __shfl_xor(ssq, 32);
            if (g4 == 0) SSQ[(hh * 8 + w) * 64 + 16 * c + i16] = ssq;
        }
    }
    __syncthreads();
    if (tid < 64) { float s = 0.f;
#pragma unroll
        for (int j = 0; j < 16; ++j) s += SSQ[j * 64 + tid];
        const float r = __builtin_amdgcn_rsqf(s * (1.f / DA) + EPS); RA[tid] = r; F_ra[q0 + tid] = r; }
    __syncthreads();
#ifdef PROBE_KREP
    if (probe & 512) return;
#endif
    LAS float* CT = (LAS float*)L;
    const int c0 = 2 * tid;
    f32x2 wv[31];
    { const float* wdw = F_w_dw + c0; asm volatile("" : "+v"(wdw));
#pragma unroll
    for (int j = 0; j < 31; ++j) wv[j] = *(const f32x2*)(wdw + j * DC); }
    const f32x2 bdw = *(const f32x2*)(F_b_dw + c0);
#pragma unroll 1
    for (int p = 0; p < 2; ++p) {
        const int rb = q0 + 32 * p;
        f32x2 o[32];
#pragma unroll
        for (int r = 0; r < 32; ++r) o[r] = bdw;
        ConvStep<0>::run(o, wv, F_glu, rb, c0);
#pragma unroll
        for (int r = 0; r < 32; ++r) *(LAS f32x2*)(CT + r * P3_CTP + c0) = o[r];
        __syncthreads();
#pragma unroll 1
        for (int rr = 0; rr < 4; ++rr) { const int r = 4 * w + rr, row = rb + r;
            f32x4 v[4]; float s1 = 0.f;
#pragma unroll
            for (int jj = 0; jj < 4; ++jj) { v[jj] = *(const LAS f32x4*)(CT + r * P3_CTP + 4 * lane + 256 * jj); s1 += (v[jj].x + v[jj].y) + (v[jj].z + v[jj].w); }
            const float mean = wave_sum(s1) * (1.f / DC); float s2 = 0.f;
#pragma unroll
            for (int jj = 0; jj < 4; ++jj) { v[jj] = v[jj] - mean; s2 += (v[jj].x * v[jj].x + v[jj].y * v[jj].y) + (v[jj].z * v[jj].z + v[jj].w * v[jj].w); }
            const float rstd = __builtin_amdgcn_rsqf(wave_sum(s2) * (1.f / DC) + EPS); float s3 = 0.f;
#pragma unroll
            for (int jj = 0; jj < 4; ++jj) { const int cc = 4 * lane + 256 * jj; const f32x4 y = v[jj] * rstd * *(const f32x4*)(F_ln_g + cc) + *(const f32x4*)(F_ln_b + cc); f32x4 z;
#pragma unroll
                for (int j = 0; j < 4; ++j) z[j] = y[j] * __builtin_amdgcn_rcpf(1.f + __builtin_amdgcn_exp2f(-LOG2E * y[j]));
                v[jj] = z; s3 += (z.x * z.x + z.y * z.y) + (z.z * z.z + z.w * z.w); }
            const float fac = __builtin_amdgcn_rsqf(wave_sum(s3) * (1.f / DC) + EPS) / RA[32 * p + r];
#pragma unroll
            for (int jj = 0; jj < 4; ++jj) { const int cc = 4 * lane + 256 * jj; const f32x4 z = v[jj] * fac * *(const f32x4*)(F_g_out_conv + cc);
                *(unsigned*)(F_mix + (size_t)row * D + DA + cc) = pk4_fp8(z.x, z.y, z.z, z.w); }
        }
        __syncthreads();
    }
}

__device__ __forceinline__ void ph5_iter(Frame& F, int it) {
    LAS float* P = (LAS float*)F.lds;
    LAS float* SS = P + 8 * 64 * 32;
    LAS int* LC = (LAS int*)(SS + 512);
    const int tid = F.tid, lane = F.lane, w = F.wave, i16 = lane & 15, g4 = lane >> 4, rb = 64 * it;
    if (tid < 64) LC[tid] = 0;
    f32x4 acc[4][2]; float ssl[4];
#pragma unroll
    for (int t = 0; t < 4; ++t) { acc[t][0] = (f32x4){0.f, 0.f, 0.f, 0.f}; acc[t][1] = acc[t][0]; ssl[t] = 0.f; }
#pragma unroll 1
    for (int blk = 0; blk < 4; ++blk) {
        const int kb = 256 * w + 64 * blk + 16 * g4;
        f32x4 gv[4];
#pragma unroll
        for (int jj = 0; jj < 4; ++jj) gv[jj] = *(const f32x4*)(F_g_norm2 + kb + 4 * jj) * (modv4(F, 4 * D + kb + 4 * jj) + 1.0f);
        f32x4 xv[4][4];
#pragma unroll
        for (int t = 0; t < 4; ++t)
#pragma unroll
            for (int jj = 0; jj < 4; jj += 2) { const u32x4 pv = *(const u32x4*)(F_x1b + (size_t)(rb + 16 * t + i16) * D + kb + 4 * jj);
                xv[t][jj] = (f32x4){bf_lo(pv.x), bf_hi(pv.x), bf_lo(pv.y), bf_hi(pv.y)}; xv[t][jj + 1] = (f32x4){bf_lo(pv.z), bf_hi(pv.z), bf_lo(pv.w), bf_hi(pv.w)}; }
#pragma unroll
        for (int t = 0; t < 4; ++t) { u32x4 w0; f32x4 y[4];
#pragma unroll
            for (int jj = 0; jj < 4; ++jj) { const f32x4 xx = xv[t][jj]; ssl[t] += (xx.x * xx.x + xx.y * xx.y) + (xx.z * xx.z + xx.w * xx.w); y[jj] = xx * gv[jj]; }
            w0.x = pk4_fp8(y[0].x, y[0].y, y[0].z, y[0].w); w0.y = pk4_fp8(y[1].x, y[1].y, y[1].z, y[1].w); w0.z = pk4_fp8(y[2].x, y[2].y, y[2].z, y[2].w); w0.w = pk4_fp8(y[3].x, y[3].y, y[3].z, y[3].w);
            *(u32x4*)(F_h8 + (size_t)(rb + 16 * t + i16) * D + kb) = w0; }
#pragma unroll
        for (int s = 0; s < 16; ++s) { const float b0 = F_wr2[(kb + s) * NE + i16], b1 = F_wr2[(kb + s) * NE + 16 + i16];
#pragma unroll
            for (int t = 0; t < 4; ++t) { const float a = xv[t][s >> 2][s & 3];
                acc[t][0] = __builtin_amdgcn_mfma_f32_16x16x4f32(a, b0, acc[t][0], 0, 0, 0); acc[t][1] = __builtin_amdgcn_mfma_f32_16x16x4f32(a, b1, acc[t][1], 0, 0, 0); } }
    }
    int i16b = i16, g4b = g4; asm volatile("" : "+v"(i16b), "+v"(g4b));
#pragma unroll
    for (int t = 0; t < 4; ++t) {
#pragma unroll
        for (int hf = 0; hf < 2; ++hf)
#pragma unroll
            for (int r = 0; r < 4; ++r) P[(w * 64 + 16 * t + 4 * g4b + r) * 32 + 16 * hf + i16b] = acc[t][hf][r];
        float v = ssl[t]; v += __shfl_xor(v, 16); v += __shfl_xor(v, 32); if (g4b == 0) SS[w * 64 + 16 * t + i16b] = v; }
    __syncthreads();
    int ek[4] = {0, 0, 0, 0}; int lr[4] = {0, 0, 0, 0}; float wk[4] = {0.f, 0.f, 0.f, 0.f}; float rr = 0.f; const int tok = rb + tid;
    if (tid < 64) {
        float lg[32]; float ssum = 0.f; int tidb = tid; asm volatile("" : "+v"(tidb));
#pragma unroll
        for (int e = 0; e < 32; ++e) lg[e] = 0.f;
#pragma unroll
        for (int ww = 0; ww < 8; ++ww) { ssum += SS[ww * 64 + tidb];
#pragma unroll
            for (int e4 = 0; e4 < 8; ++e4) { const f32x4 t4 = *(const LAS f32x4*)(P + (ww * 64 + tidb) * 32 + 4 * e4); lg[4 * e4] += t4.x; lg[4 * e4 + 1] += t4.y; lg[4 * e4 + 2] += t4.z; lg[4 * e4 + 3] += t4.w; } }
        rr = __builtin_amdgcn_rsqf(ssum * (1.f / D) + EPS);
#pragma unroll
        for (int e = 0; e < 32; ++e) lg[e] = lg[e] * rr + F_cvr[e];
        float vk[4];
#pragma unroll
        for (int k = 0; k < 4; ++k) { float best = -3.0e38f; int bi = 0;
#pragma unroll
            for (int e = 0; e < 32; ++e) { bool ok = lg[e] > best;
#pragma unroll
                for (int p = 0; p < 4; ++p) if (p < k) ok = ok && (ek[p] != e);
                best = ok ? lg[e] : best; bi = ok ? e : bi; }
            ek[k] = bi; vk[k] = best; }
        const float e1 = __expf(vk[1] - vk[0]), e2 = __expf(vk[2] - vk[0]), e3 = __expf(vk[3] - vk[0]); const float inv = 1.0f / (1.0f + e1 + e2 + e3);
        wk[0] = inv; wk[1] = e1 * inv; wk[2] = e2 * inv; wk[3] = e3 * inv;
#pragma unroll
        for (int k = 0; k < 4; ++k) lr[k] = __hip_atomic_fetch_add(LC + ek[k], 1, __ATOMIC_RELAXED, __HIP_MEMORY_SCOPE_WORKGROUP);
    }
    __syncthreads();
    if (tid < 32) { const int n = LC[tid]; int base = 0; if (n > 0) base = (int)__hip_atomic_fetch_add(F_ctl + CW_CNT + 64 * tid, (unsigned)n, RLX_AGENT); LC[32 + tid] = base; }
    __syncthreads();
    if (tid < 64) {
#pragma unroll
        for (int k = 0; k < 4; ++k) { const int pos = LC[32 + ek[k]] + lr[k]; u32x4 en; en.x = (unsigned)(tok * 4 + k); en.y = __float_as_uint(rr); en.z = __float_as_uint(wk[k]); en.w = 0u; F_list[(size_t)ek[k] * LCAP + pos] = en; }
    }
    __syncthreads();
}

__device__ __forceinline__ int moe_tables(Frame& F, int npn) {
    LAS int* tab = (LAS int*)(F.lds + MISC_OFF + 64);
    __syncthreads();
    if (F.tid < 32) tab[F.tid] = (int)__hip_atomic_load(F_ctl + CW_CNT + 64 * F.tid, RLX_AGENT);
    __syncthreads();
    if (F.tid == 0) { int pu = 0, pt = 0; for (int e = 0; e < 32; ++e) { tab[32 + e] = pu; tab[65 + e] = pt; const int nt = (tab[e] + 255) >> 8; pu += nt * npn; pt += nt; } tab[64] = pu; tab[97] = pt; }
    __syncthreads();
    return __builtin_amdgcn_readfirstlane(tab[64]);
}

__device__ __forceinline__ f32x4 fp8x4_to_f32(unsigned w) { const f32x2 lo = __builtin_amdgcn_cvt_pk_f32_fp8((int)w, false), hi = __builtin_amdgcn_cvt_pk_f32_fp8((int)w, true); return (f32x4){lo.x, lo.y, hi.x, hi.y}; }
__device__ __forceinline__ void ph8_final(Frame& F) {
    const int gw = F.vcu * 8 + F.wave, NGW = F.G * 8, lane = F.lane;
    f32x4 g2[2][4];
#pragma unroll
    for (int jj = 0; jj < 2; ++jj)
#pragma unroll
        for (int q = 0; q < 4; ++q) g2[jj][q] = modv4(F, 5 * D + 16 * lane + 1024 * jj + 4 * q) * (1.0f / PART_MUL);
    for (int row = gw; row < T; row += NGW) {
#pragma unroll
        for (int jj = 0; jj < 2; ++jj) { const int col = 16 * lane + 1024 * jj; float* op = F_out + (size_t)row * D + col;
            f32x4 a[4];
#pragma unroll
            for (int q = 0; q < 4; ++q) a[q] = (f32x4){0.f, 0.f, 0.f, 0.f};
#pragma unroll
            for (int s = 0; s < 4; ++s) { const u32x4 pv = __builtin_nontemporal_load((const u32x4*)(F_part + ((size_t)s * T + row) * D + col));
                a[0] += fp8x4_to_f32(pv.x); a[1] += fp8x4_to_f32(pv.y); a[2] += fp8x4_to_f32(pv.z); a[3] += fp8x4_to_f32(pv.w); }
            const u32x4 xa = __builtin_nontemporal_load((const u32x4*)(F_x1b + (size_t)row * D + col)), xb = __builtin_nontemporal_load((const u32x4*)(F_x1b + (size_t)row * D + col + 8));
            __builtin_nontemporal_store((f32x4){bf_lo(xa.x), bf_hi(xa.x), bf_lo(xa.y), bf_hi(xa.y)} + g2[jj][0] * a[0], (f32x4*)op);
            __builtin_nontemporal_store((f32x4){bf_lo(xa.z), bf_hi(xa.z), bf_lo(xa.w), bf_hi(xa.w)} + g2[jj][1] * a[1], (f32x4*)(op + 4));
            __builtin_nontemporal_store((f32x4){bf_lo(xb.x), bf_hi(xb.x), bf_lo(xb.y), bf_hi(xb.y)} + g2[jj][2] * a[2], (f32x4*)(op + 8));
            __builtin_nontemporal_store((f32x4){bf_lo(xb.z), bf_hi(xb.z), bf_lo(xb.w), bf_hi(xb.w)} + g2[jj][3] * a[3], (f32x4*)(op + 12)); }
    }
}

__global__ void __launch_bounds__(512, 2) fwd_kernel(Args args) {
    extern __shared__ __attribute__((aligned(16))) unsigned char lds[];
    Frame F;
    F.lds = (LAS unsigned char*)lds;
    F.tid = threadIdx.x; F.lane = F.tid & 63; F.wave = __builtin_amdgcn_readfirstlane(F.tid >> 6);
    F.G = gridDim.x; { const int bx = blockIdx.x; F.vcu = (F.G % 8 == 0) ? (bx % 8) * (F.G / 8) + bx / 8 : bx; }
    F.a = &args;
    for (int u = F.tid; u < (LDS_BYTES - MISC_OFF) / 4; u += 512) ((LAS unsigned*)(F.lds + MISC_OFF))[u] = 0u;
    __syncthreads();
    XcdBarrier bar; bar.bar = F_ctl + CW_BAR; bar.x = 0; bar.st = nullptr;
    if (MK_N_LAUNCHES == 1) bar = xcd_barrier_post(F_ctl + CW_BAR, (volatile LAS unsigned*)(F.lds + MISC_OFF));
    const int lo = args.ph_lo, hi = args.ph_hi;
#define IN(k) (lo <= (k) && (k) < hi)
#define SEAM(k) do { if (MK_N_LAUNCHES == 1 && IN(k) && IN((k) + 1)) xcd_barrier(bar); } while (0)
    const int cx = (int)((blockIdx.x % 8) * (gridDim.x / 8) + blockIdx.x / 8);

    if (IN(0)) { ph0_mod(F); SEAM(0); }
    if (IN(1)) { ph0b_modsum(F); SEAM(1); }
    if (IN(2)) { ph1_prologue(F); SEAM(2); }
    if (IN(3)) {
        constexpr int NCOMP = 16;
        const int rank = (int)blockIdx.x >> 3, xcd = (int)blockIdx.x & 7;
        if (F.G != 256) {
            pg8::DenseOrder S; S.init(F_hb, F_WinT, T, DIN, F.G, (int)blockIdx.x);
            EpiInProj E{F_qb, F_kb, F_vb, F_glu, F_biasp, F_g_q, F_g_k};
            pg8::gemm_phase<EpiInProj, pg8::DenseOrder, false>(F.lds, F.lds + META_OFF, S, E, args.krep & 255);
            moe_convert(F, F.vcu * 8 + F.wave, F.G * 8, args.krep);
        } else if ((rank & 1) == 0) {
            pg8::DenseOrder S; S.init(F_hb, F_WinT, T, DIN, 8 * NCOMP, xcd + 8 * (rank >> 1));
            EpiInProj E{F_qb, F_kb, F_vb, F_glu, F_biasp, F_g_q, F_g_k};
            pg8::gemm_phase<EpiInProj, pg8::DenseOrder, false>(F.lds, F.lds + META_OFF, S, E, args.krep & 255);
        } else {
            moe_convert(F, ((xcd * (32 - NCOMP)) + (rank >> 1)) * 8 + F.wave, 8 * (32 - NCOMP) * 8, args.krep);
        }
        SEAM(3);
    }
    if (IN(4)) { for (int u = F.vcu; u < T / 64; u += F.G) ph3_unit(F, u, args.krep); SEAM(4); }
    if (IN(5)) {
        pg8::DenseOrderT<pg8::KB8> S; S.init(F_mix, F_WoutT, T, D, F.G, (int)blockIdx.x);
        EpiOut E{F_x, F_ra, F_modf, F_b_out, F_x1b};
        pg8::gemm_phase<EpiOut, pg8::DenseOrderT<pg8::KB8>, true>(F.lds, F.lds + META_OFF, S, E, args.krep & 255);
        SEAM(5);
    }
    if (IN(6)) { for (int it = blockIdx.x; it < T / 64; it += F.G) ph5_iter(F, it); SEAM(6); }
    if (IN(7)) {
        const int total = GU_MAIN(moe_tables(F, 16));
        pg8::MoeGatherT<pg8::KB8> S; S.tab = (const LAS int*)(F.lds + MISC_OFF + 64); S.npn = 16; S.G = F.G; S.c = cx; S.total = total; S.A = (const char*)F_h8; S.Bt = (const char*)F_WguT; S.bexp = (size_t)2 * D * D; S.list = F_list; S.cbase = F_cvgu; S.cexp = 4096;
#ifdef PROBE_KREP
        if (args.krep & 256) S.bexp = 0;
#endif
        EpiGU E{F_act};
        pg8::gemm_phase<EpiGU, pg8::MoeGatherT<pg8::KB8>, true>(F.lds, F.lds + META_OFF, S, E, args.krep & 255);
        SEAM(7);
    }
    if (IN(8)) {
        const int gu_total = moe_tables(F, 16), gu_main = GU_MAIN(gu_total), ov = gu_total - gu_main;
        if (cx < ov) {
            pg8::MoeGatherT<pg8::KB8> S; S.tab = (const LAS int*)(F.lds + MISC_OFF + 64); S.npn = 16; S.G = 1 << 24; S.c = gu_main + cx; S.total = gu_total; S.A = (const char*)F_h8; S.Bt = (const char*)F_WguT; S.bexp = (size_t)2 * D * D; S.list = F_list; S.cbase = F_cvgu; S.cexp = 4096;
            EpiGU E{F_act};
            pg8::gemm_phase<EpiGU, pg8::MoeGatherT<pg8::KB8>, true>(F.lds, F.lds + META_OFF, S, E, 1);
            if (F.tid == 0) { __builtin_amdgcn_fence(__ATOMIC_RELEASE, "agent"); asm volatile("s_waitcnt vmcnt(0)" ::: "memory"); (void)__hip_atomic_fetch_add(F_ctl + CW_OVF, 1u, RLX_AGENT); }
        }
        const int total = moe_tables(F, 8);
        pg8::MoeDenseT<pg8::KB8> S; S.tab = (const LAS int*)(F.lds + MISC_OFF + 64); S.npn = 8; S.G = F.G; S.c = (cx - ov + F.G) % F.G; S.total = total;
        S.dep_from = gu_main; S.dep_target = (unsigned)ov; S.dep_ctr = F_ctl + CW_OVF; S.dep_tmo = F_ctl + CW_TMO; S.A = (const char*)F_act; S.Bt = (const char*)F_WdnT; S.bexp = (size_t)D * D; S.list = F_list; S.cbase = F_b_down; S.cexp = D;
#ifdef PROBE_KREP
        if (args.krep & 256) S.bexp = 0;
#endif
        EpiDown E{F_part};
        pg8::gemm_phase<EpiDown, pg8::MoeDenseT<pg8::KB8>, true>(F.lds, F.lds + META_OFF, S, E, args.krep & 255);
        SEAM(8);
    }
    if (IN(9)) ph8_final(F);
#undef IN
#undef SEAM
}

extern "C" void kernel_launch(void* const* d_in, const int* in_sizes, int n_in, void* d_out, int out_size, void* d_ws, size_t ws_size, hipStream_t stream) {
    static int grid = 0;
    if (grid == 0) {
        if (n_in != 28 || out_size != T * D || ws_size < WS_END) { fprintf(stderr, "kernel_launch: unexpected shapes (n_in %d, out %d, ws %zu)\n", n_in, out_size, ws_size); grid = -1; return; }
        int dev = 0, cus = 0, per_cu = 0;
        if (hipGetDevice(&dev) != hipSuccess || hipDeviceGetAttribute(&cus, hipDeviceAttributeMultiprocessorCount, dev) != hipSuccess) { grid = -1; return; }
        if (hipFuncSetAttribute((const void*)fwd_kernel, hipFuncAttributeMaxDynamicSharedMemorySize, LDS_BYTES) != hipSuccess) { fprintf(stderr, "kernel_launch: hipFuncSetAttribute failed\n"); grid = -1; return; }
        if (hipOccupancyMaxActiveBlocksPerMultiprocessor(&per_cu, (const void*)fwd_kernel, 512, LDS_BYTES) != hipSuccess || per_cu < 1) { fprintf(stderr, "kernel_launch: occupancy query says %d\n", per_cu); (void)hipGetLastError(); }
        grid = cus;
    }
    if (grid < 0) return;
    (void)in_sizes;
    if (hipMemsetAsync((char*)d_ws + WS_CTL, 0, CTL_ZERO_BYTES, stream) != hipSuccess) return;
    Args a{};
    for (int i = 0; i < 28; ++i) a.in[i] = (const float*)d_in[i];
    a.out = (float*)d_out; a.ws = (unsigned char*)d_ws;
    a.krep = 1; a.pad = 0;
    if (MK_N_LAUNCHES == 1) { a.ph_lo = 0; a.ph_hi = NPHASE; hipLaunchKernelGGL(fwd_kernel, dim3(grid), dim3(512), LDS_BYTES, stream, a); }
    else for (int p = 0; p < NPHASE; ++p) { a.ph_lo = p; a.ph_hi = p + 1;
#ifdef DUP_PHASE
        if (p == DUP_PHASE) {
#ifdef PROBE_KREP
            a.krep = PROBE_KREP;
#endif
            hipLaunchKernelGGL(fwd_kernel, dim3(grid), dim3(512), LDS_BYTES, stream, a); a.krep = 1; }
#endif
        hipLaunchKernelGGL(fwd_kernel, dim3(grid), dim3(512), LDS_BYTES, stream, a);
    }
}
```

```cpp
#include <hip/hip_runtime.h>
#include <cstdio>
#include <cstdint>

#ifdef FORCE_OV
#define GU_MAIN(t) ((t) - FORCE_OV)
#else
#define GU_MAIN(t) (((t) / F.G) * F.G)
#endif
#ifndef MK_N_LAUNCHES
#define MK_N_LAUNCHES 1
#endif

#define LAS __attribute__((address_space(3)))
#define GAS __attribute__((address_space(1)))
typedef unsigned short bf16;
typedef short bf16x8 __attribute__((ext_vector_type(8)));
typedef short s16x4 __attribute__((ext_vector_type(4)));
typedef float f32x4 __attribute__((ext_vector_type(4)));
typedef float f32x2 __attribute__((ext_vector_type(2)));
typedef unsigned u32x4 __attribute__((ext_vector_type(4)));
typedef unsigned u32x2 __attribute__((ext_vector_type(2)));
typedef int i32x4 __attribute__((ext_vector_type(4)));
typedef int i32x8 __attribute__((ext_vector_type(8)));
constexpr int W8_SHIFT = 5; constexpr int W8_SCALE_E8 = (127 - W8_SHIFT) * 0x01010101; constexpr float W8_MUL = 32.0f;
__device__ __forceinline__ unsigned pk_hi_lo_fp8(f32x2 lo, f32x2 hi) { unsigned w = __builtin_amdgcn_cvt_pk_fp8_f32(hi.x, hi.y, __float_as_uint(hi.x), true); return __builtin_amdgcn_cvt_pk_fp8_f32(lo.x, lo.y, w, false); }
__device__ __forceinline__ unsigned pk4_fp8(float a, float b, float c, float d) { unsigned w = 0u; w = __builtin_amdgcn_cvt_pk_fp8_f32(a, b, w, false); w = __builtin_amdgcn_cvt_pk_fp8_f32(c, d, w, true); return w; }

constexpr int T = 16384, D = 2048, DIN = 3328, DA = 1024, DKV = 128, DC = 1024, NE = 32, NH = 16;
constexpr int LCAP = 16384;
constexpr float EPS = 1e-6f, LOG2E = 1.4426950408889634f, QSCALE = 0.125f * 1.4426950408889634f;
constexpr int NPHASE = 10;

constexpr size_t MiB = 1u << 20;
constexpr size_t WS_CTL = 0, CTL_BYTES = 1 * MiB, CTL_ZERO_BYTES = 64 * 1024;
constexpr size_t WS_WIN = 2 * MiB;
constexpr size_t WS_WOUT = 16 * MiB;
constexpr size_t WS_MISC = 24 * MiB;
constexpr size_t WS_H = 32 * MiB;
constexpr size_t WS_Q = 96 * MiB;
constexpr size_t WS_K = 128 * MiB;
constexpr size_t WS_V = 132 * MiB;
constexpr size_t WS_GLU = 136 * MiB;
constexpr size_t WS_MIX = 168 * MiB;
constexpr size_t WS_WGU = 256 * MiB;
constexpr size_t WS_WDN = 512 * MiB;
constexpr size_t WS_ACT = 640 * MiB;
constexpr size_t WS_PART = 784 * MiB;
constexpr size_t WS_H8 = 1040 * MiB;
constexpr size_t WS_LIST = 1072 * MiB;
constexpr size_t WS_END = 1080 * MiB;
constexpr int CW_TMO = 0;
constexpr int CW_BAR = 4096;
constexpr int CW_CNT = 8192;
constexpr int CW_OVF = 10240;
constexpr int CW_MOD = 16384;
constexpr int CW_CVR = 28672;
constexpr int CW_CVGU = 65536;
static_assert((CW_CVGU + 32 * 4096) * 4 <= (int)CTL_BYTES && (CW_CNT + 32 * 64) * 4 <= (int)CTL_ZERO_BYTES && (CW_BAR + 3456) * 4 <= (int)CTL_ZERO_BYTES, "ctl");
constexpr size_t MS_BIASP = 0;
constexpr size_t MS_RA = 64 * 1024;
constexpr size_t MS_TOPW = 256 * 1024;
constexpr size_t MS_WR2 = 1 * MiB;
constexpr size_t MS_LIST = 2 * MiB;
constexpr size_t MS_MODP = 6 * MiB;

constexpr int RING_BYTES = 131072;
constexpr int META_OFF = 131840;
constexpr int MISC_OFF = 142336;
constexpr int LDS_BYTES = 143360;
constexpr int P3_K = 0, P3_V = 55296, P3_TAB = 110592, P3_SSQ = 118784, P3_RA = 131584, P3_CTP = 1028;

#define LDS_WAIT() asm volatile("s_waitcnt lgkmcnt(0)" ::: "memory")
#define VM_WAIT() asm volatile("s_waitcnt vmcnt(0)" ::: "memory")
#define RLX_AGENT __ATOMIC_RELAXED, __HIP_MEMORY_SCOPE_AGENT

__device__ __forceinline__ unsigned cvt_pk_bf16(float lo, float hi) { unsigned r; asm volatile("v_cvt_pk_bf16_f32 %0, %1, %2" : "=v"(r) : "v"(lo), "v"(hi)); return r; }
__device__ __forceinline__ float wave_sum(float v) {
#pragma unroll
    for (int o = 1; o < 64; o <<= 1) v += __shfl_xor(v, o);
    return v;
}
__device__ __forceinline__ void wave_sum4(float (&v)[4]) {
#pragma unroll
    for (int o = 1; o < 64; o <<= 1) {
#pragma unroll
        for (int k = 0; k < 4; ++k) v[k] += __shfl_xor(v[k], o); }
}
__device__ __forceinline__ float bf_lo(unsigned v) { return __builtin_bit_cast(float, v << 16); }
__device__ __forceinline__ float bf_hi(unsigned v) { return __builtin_bit_cast(float, v & 0xffff0000u); }

namespace pg8 {
constexpr int BM = 256, BK = 64, HALF = 128, HTB = HALF * BK * 2, STAGE_BYTES = 8 * HTB, NXCD = 8, WGM = 8;
constexpr int KB16 = 4096, KB8 = 2048;
__host__ __device__ __forceinline__ int lds_byte(int r, int c) { const int st = (r >> 4) * 2 + (c >> 5), rr = r & 15, cc = c & 31, ob = rr * 64 + cc * 2; return st * 1024 + (ob ^ (((ob >> 9) & 1) << 5)); }
__host__ __device__ __forceinline__ void stage_rc(int b, int& R, int& C) { const int st = b / 1024, sb = b % 1024, swz = sb ^ (((sb >> 9) & 1) << 5); R = (st >> 1) * 16 + swz / 64; C = (st & 1) * 32 + (swz % 64) / 2; }
__host__ __device__ __forceinline__ int perm32(int rho) { const int n = rho >> 4, i = rho & 15; return 8 * (i >> 2) + 4 * n + (i & 3); }

struct Unit { int pm, pn, e, m, nv, nt; };
constexpr size_t KSTEP = 128;

template <int KB> struct DenseOrderT {
    static constexpr bool META = false, DEP = false;
    static constexpr size_t HSTEP = (size_t)HALF * KB, TSTEP = 2 * HSTEP;
    const char* A; const char* Bt; int nM, nN, nwg, G, c;
    __device__ void init(const void* A_, const void* Bt_, int M, int N, int G_, int c_) { A = (const char*)A_; Bt = (const char*)Bt_; nM = M / BM; nN = N / BM; nwg = nM * nN; G = G_; c = c_; }
    __device__ __forceinline__ bool next(int i, Unit& u) const {
        const int L = i * G + c; if (L >= nwg) return false;
        int wgid = L; { const int q = nwg / NXCD, r = nwg % NXCD, xcd = wgid % NXCD, off = wgid / NXCD; wgid = (xcd < r ? xcd * (q + 1) : r * (q + 1) + (xcd - r) * q) + off; }
        const int nig = WGM * nN, gid = wgid / nig, fm = gid * WGM, gsz = (nM - fm) < WGM ? (nM - fm) : WGM;
        u.pm = fm + ((wgid % nig) % gsz); u.pn = (wgid % nig) / gsz; u.e = 0; u.m = 0; u.nv = 256; u.nt = 1; return true;
    }
    __device__ __forceinline__ const char* a_base(const Unit& u) const { return A + (size_t)u.pm * TSTEP; }
    __device__ __forceinline__ const char* b_base(const Unit& u) const { return Bt + (size_t)u.pn * TSTEP; }
    __device__ __forceinline__ void a_off(const Unit&, unsigned (&v)[2][2], int tid, const LAS unsigned char*) const {
        int R[2], C[2]; stage_rc(tid * 16, R[0], C[0]); stage_rc(tid * 16 + 8192, R[1], C[1]);
#pragma unroll
        for (int h = 0; h < 2; ++h)
#pragma unroll
            for (int i = 0; i < 2; ++i) v[h][i] = (unsigned)(h * (int)HSTEP) + (unsigned)(R[i] * KB + C[i] * 2);
    }
    __device__ __forceinline__ void meta_issue(const Unit&, LAS unsigned char*, LAS unsigned char*, int, int) const {}
};
typedef DenseOrderT<KB16> DenseOrder;
template <int KB> struct MoeOrderT {
    static constexpr bool META = true;
    static constexpr size_t HSTEP = (size_t)HALF * KB, TSTEP = 2 * HSTEP;
    const LAS int* tab; int npn, G, c, total;
    const char* A; const char* Bt; size_t bexp; const u32x4* list; const float* cbase; int cexp;
    __device__ __forceinline__ bool next(int i, Unit& u) const {
        const int L = i * G + c; if (L >= total) return false;
        int e = 0;
        for (int j = 1; j < 32; ++j) e += (L >= tab[32 + j]) ? 1 : 0;
        e = __builtin_amdgcn_readfirstlane(e);
        const int p0 = __builtin_amdgcn_readfirstlane(tab[32 + e]), p1 = __builtin_amdgcn_readfirstlane(tab[33 + e]);
        const int cnt = __builtin_amdgcn_readfirstlane(tab[e]), t0 = __builtin_amdgcn_readfirstlane(tab[65 + e]);
        const int nt = (p1 - p0) / npn, rem = L - p0;
        u.pn = rem / nt; u.m = rem - u.pn * nt; u.e = e; u.nt = nt; u.pm = t0 + u.m; const int left = cnt - 256 * u.m; u.nv = left < 256 ? left : 256; return true;
    }
    __device__ __forceinline__ const char* b_base(const Unit& u) const { return Bt + (size_t)u.e * bexp + (size_t)u.pn * TSTEP; }
    __device__ __forceinline__ void meta_issue(const Unit& u, LAS unsigned char* eb, LAS unsigned char* cb, int wid, int lane) const {
        if (wid < 4) __builtin_amdgcn_global_load_lds((const unsigned*)(list + (size_t)u.e * LCAP + 256 * u.m + 64 * wid + lane), (LAS unsigned*)(eb + wid * 1024), 16, 0, 0);
        else if (wid == 4) __builtin_amdgcn_global_load_lds((const unsigned*)(cbase + (size_t)u.e * cexp + u.pn * 256 + 4 * lane), (LAS unsigned*)cb, 16, 0, 0);
    }
};
template <int KB> struct MoeGatherT : MoeOrderT<KB> {
    static constexpr bool DEP = false;
    using MoeOrderT<KB>::A;
    __device__ __forceinline__ const char* a_base(const Unit&) const { return A; }
    __device__ __forceinline__ void a_off(const Unit& u, unsigned (&v)[2][2], int tid, const LAS unsigned char* eb) const {
        int R[2], C[2]; stage_rc(tid * 16, R[0], C[0]); stage_rc(tid * 16 + 8192, R[1], C[1]);
#pragma unroll
        for (int h = 0; h < 2; ++h)
#pragma unroll
            for (int i = 0; i < 2; ++i) { const int pos = 128 * h + R[i]; unsigned ts = *(const LAS unsigned*)(eb + pos * 16); ts = pos < u.nv ? ts : 0u;
                v[h][i] = (ts >> 2) * (unsigned)KB + (unsigned)C[i] * 2u; }
    }
};
template <int KB> struct MoeDenseT : MoeOrderT<KB> {
    static constexpr bool DEP = true;
    int dep_from; unsigned dep_target; unsigned* dep_ctr; unsigned* dep_tmo;
    __device__ __forceinline__ bool dep(const Unit& u) const { return 16 * (u.pm - u.m) + 15 * u.nt + u.m >= dep_from; }
    __device__ __forceinline__ void dep_wait() const {
        unsigned sp = 0u;
        while (__hip_atomic_load(dep_ctr, __ATOMIC_RELAXED, __HIP_MEMORY_SCOPE_AGENT) < dep_target) { __builtin_amdgcn_s_sleep(1); if (++sp > (1u << 20)) { atomicAdd(dep_tmo, 1u); break; } }
        __builtin_amdgcn_fence(__ATOMIC_ACQUIRE, "agent");
        asm volatile("s_waitcnt vmcnt(0)" ::: "memory");
    }
    using MoeOrderT<KB>::A; using MoeOrderT<KB>::HSTEP; using MoeOrderT<KB>::TSTEP;
    __device__ __forceinline__ const char* a_base(const Unit& u) const { return A + (size_t)u.pm * TSTEP; }
    __device__ __forceinline__ void a_off(const Unit&, unsigned (&v)[2][2], int tid, const LAS unsigned char*) const {
        int R[2], C[2]; stage_rc(tid * 16, R[0], C[0]); stage_rc(tid * 16 + 8192, R[1], C[1]);
#pragma unroll
        for (int h = 0; h < 2; ++h)
#pragma unroll
            for (int i = 0; i < 2; ++i) v[h][i] = (unsigned)(h * (int)HSTEP) + (unsigned)(R[i] * KB + C[i] * 2);
    }
};

template <class Epi, class Sched, bool FP8>
__device__ __forceinline__ void gemm_phase(LAS unsigned char* lds, LAS unsigned char* meta, const Sched& S, const Epi& E, int krep = 1) {
    constexpr int KB = FP8 ? KB8 : KB16, NT = KB / 128;
    constexpr size_t HSTEP = (size_t)HALF * KB;
    const int tid = threadIdx.x, wid = __builtin_amdgcn_readfirstlane(tid >> 6), lane = tid & 63, wr = wid >> 2, wc = wid & 3, fr = lane & 15, fq = lane >> 4;
#ifdef PROBE_KREP
    const bool PG8_PROBE_NOSTAGE = (krep & 32) != 0, PG8_PROBE_NOMMA = (krep & 64) != 0, PG8_PROBE_NOEPI = (krep & 128) != 0; krep &= 15;
#else
    constexpr bool PG8_PROBE_NOSTAGE = false, PG8_PROBE_NOMMA = false, PG8_PROBE_NOEPI = false;
#endif
    unsigned voffB[2];
#pragma unroll
    for (int i = 0; i < 2; ++i) { int R, C; stage_rc(tid * 16 + i * 8192, R, C); const int Rb = Epi::PERM ? ((R & ~31) + perm32(R & 31)) : R;
        voffB[i] = (unsigned)(Rb * KB + C * 2); }
    const size_t kstep = KSTEP, hstep = HSTEP;
    const unsigned ldsw = (unsigned)wid * 1024u;
    const int aoff = lds_byte(wr * 64 + fr, fq * 8), boff = lds_byte(wc * 32 + fr, fq * 8);
#define PG8_SA(b, h) (((b) * 2 + (h)) * HTB)
#define PG8_SB(b, h) ((4 + (b) * 2 + (h)) * HTB)
#define PG8_STAGE(bufoff, gbase, voff) do { if (PG8_PROBE_NOSTAGE) break; _Pragma("unroll") for (int _i = 0; _i < 2; ++_i) \
        __builtin_amdgcn_global_load_lds((const unsigned*)((const char*)(gbase) + (voff)[_i]), (LAS unsigned*)(lds + (bufoff) + ldsw + _i * 8192), 16, 0, 0); } while (0)
#define PG8_LDA(dst, b, h) do { _Pragma("unroll") for (int m = 0; m < 4; ++m) { if constexpr (FP8) { dst##8[m].lo = *(const LAS i32x4*)(lds + PG8_SA(b, h) + aoff + m * 2048); dst##8[m].hi = *(const LAS i32x4*)(lds + PG8_SA(b, h) + aoff + m * 2048 + 1024); } \
        else { _Pragma("unroll") for (int k = 0; k < 2; ++k) dst[m][k] = *(const LAS bf16x8*)(lds + PG8_SA(b, h) + aoff + m * 2048 + k * 1024); } } } while (0)
#define PG8_LDB(dst, b, h) do { _Pragma("unroll") for (int n = 0; n < 2; ++n) { if constexpr (FP8) { dst##8[n].lo = *(const LAS i32x4*)(lds + PG8_SB(b, h) + boff + n * 2048); dst##8[n].hi = *(const LAS i32x4*)(lds + PG8_SB(b, h) + boff + n * 2048 + 1024); } \
        else { _Pragma("unroll") for (int k = 0; k < 2; ++k) dst[n][k] = *(const LAS bf16x8*)(lds + PG8_SB(b, h) + boff + n * 2048 + k * 1024); } } } while (0)
#define PG8_MMA(ai, bj, At, Bt) do { if (PG8_PROBE_NOMMA) break; __builtin_amdgcn_s_setprio(1); _Pragma("unroll") for (int m = 0; m < 4; ++m) _Pragma("unroll") for (int n = 0; n < 2; ++n) { \
        if constexpr (FP8) asm volatile("v_mfma_scale_f32_16x16x128_f8f6f4 %0, %1, %2, %0, %3, %4 op_sel_hi:[0,0,0]" : "+v"(acc[ai][bj][m][n]) : "v"(Bt##8[n]), "v"(At##8[m]), "v"(sclw), "v"(scl1)); \
        else { _Pragma("unroll") for (int k = 0; k < 2; ++k) acc[ai][bj][m][n] = __builtin_amdgcn_mfma_f32_16x16x32_bf16(Bt[n][k], At[m][k], acc[ai][bj][m][n], 0, 0, 0); } } \
        __builtin_amdgcn_s_setprio(0); } while (0)
#define PG8_WAIT_V(n) asm volatile("s_waitcnt vmcnt(" #n ")" ::: "memory")
#define PG8_WAIT_L(n) asm volatile("s_waitcnt lgkmcnt(" #n ")" ::: "memory")
#define PG8_BAR __builtin_amdgcn_s_barrier()
#define PG8_SCHED __builtin_amdgcn_sched_barrier(0)
    Unit cur, nxt; int ui = 0;
    if (!S.next(0, cur)) return;
    nxt = cur;
    f32x4 acc[2][2][4][2];
#pragma unroll
    for (int a = 0; a < 2; ++a)
#pragma unroll
        for (int b = 0; b < 2; ++b)
#pragma unroll
            for (int m = 0; m < 4; ++m)
#pragma unroll
                for (int n = 0; n < 2; ++n) acc[a][b][m][n] = (f32x4){0.f, 0.f, 0.f, 0.f};
    bf16x8 At[4][2], B0[2][2], B1[2][2]; i32x8 At8[4], B08[2], B18[2];
    unsigned cv[2][2], nv[2][2];
    int sclw = 0, scl1 = 0;
    if constexpr (FP8) { asm volatile("v_mov_b32 %0, %2\n\tv_mov_b32 %1, %3" : "=v"(sclw), "=v"(scl1) : "s"(W8_SCALE_E8), "s"(0x7F7F7F7F)); }
#define PG8_EB(par) (meta + (par) * 4096)
#define PG8_CB(par) (meta + 8192 + (par) * 1024)
    if constexpr (Sched::DEP) { if (S.dep(cur)) { if (wid == 7) S.dep_wait(); } }
    if constexpr (Sched::META) { S.meta_issue(cur, PG8_EB(0), PG8_CB(0), wid, lane); PG8_WAIT_V(0); PG8_BAR; }
    S.a_off(cur, cv, tid, PG8_EB(0));
#pragma unroll
    for (int h = 0; h < 2; ++h)
#pragma unroll
        for (int i = 0; i < 2; ++i) nv[h][i] = cv[h][i];
    const char* cA = S.a_base(cur); const char* cB = S.b_base(cur);
    PG8_STAGE(PG8_SB(0, 0), cB, voffB); PG8_STAGE(PG8_SB(0, 1), cB + hstep, voffB); PG8_STAGE(PG8_SA(0, 0), cA, cv[0]); PG8_STAGE(PG8_SA(0, 1), cA, cv[1]);
    if (wr == 1) PG8_BAR;
    PG8_WAIT_V(2); PG8_BAR;
    PG8_STAGE(PG8_SB(1, 0), cB + kstep, voffB); PG8_STAGE(PG8_SA(1, 0), cA + kstep, cv[0]); PG8_STAGE(PG8_SB(1, 1), cB + hstep + kstep, voffB);
    PG8_WAIT_V(6); PG8_BAR;
    for (;;) {
        const bool has_next = S.next(ui + 1, nxt);
        const char* nA = has_next ? S.a_base(nxt) : cA; const char* nB = has_next ? S.b_base(nxt) : cB;
#ifdef PROBE_KREP
        const int ntk = NT * krep;
#else
        constexpr int ntk = NT;
#endif
#pragma unroll 1
        for (int tt = 0; tt < ntk; tt += 2) {
            const int t = tt & (NT - 1);
            const bool last = (tt == ntk - 2);
            const char* a1 = cA + (size_t)(t + 1) * kstep;
            if (last && has_next) S.a_off(nxt, nv, tid, PG8_EB((ui + 1) & 1));
            const char* a2 = last ? nA : cA + (size_t)(t + 2) * kstep; const char* b2 = last ? nB : cB + (size_t)(t + 2) * kstep;
            const char* a3 = a2 + kstep; const char* b3 = b2 + kstep;
            unsigned s2[2][2];
#pragma unroll
            for (int h = 0; h < 2; ++h)
#pragma unroll
                for (int i = 0; i < 2; ++i) s2[h][i] = last ? nv[h][i] : cv[h][i];
            PG8_LDB(B0, 0, 0); PG8_LDB(B1, 0, 1); PG8_SCHED; PG8_LDA(At, 0, 0); PG8_STAGE(PG8_SA(1, 1), a1, cv[1]);
            PG8_WAIT_V(8); PG8_WAIT_L(0); PG8_BAR; PG8_MMA(0, 0, At, B0); PG8_MMA(0, 1, At, B1); PG8_BAR; PG8_SCHED;
            if constexpr (Sched::DEP) { if (tt == 0 && has_next && S.dep(nxt)) { if (wid == 7) S.dep_wait(); } }
            if constexpr (Sched::META) { if (tt == 0 && has_next) S.meta_issue(nxt, PG8_EB((ui + 1) & 1), PG8_CB((ui + 1) & 1), wid, lane); }
            PG8_LDA(At, 0, 1); PG8_STAGE(PG8_SB(0, 0), b2, voffB); PG8_STAGE(PG8_SB(0, 1), b2 + hstep, voffB); PG8_STAGE(PG8_SA(0, 0), a2, s2[0]);
            PG8_WAIT_V(8); PG8_WAIT_L(0); PG8_BAR; PG8_MMA(1, 0, At, B0); PG8_MMA(1, 1, At, B1); PG8_BAR; PG8_SCHED;
            PG8_LDB(B0, 1, 0); PG8_LDB(B1, 1, 1); PG8_SCHED; PG8_LDA(At, 1, 0); PG8_STAGE(PG8_SA(0, 1), a2, s2[1]);
            PG8_WAIT_V(8); PG8_WAIT_L(0); PG8_BAR; PG8_MMA(0, 0, At, B0); PG8_MMA(0, 1, At, B1); PG8_BAR; PG8_SCHED;
            PG8_LDA(At, 1, 1); PG8_STAGE(PG8_SB(1, 0), b3, voffB); PG8_STAGE(PG8_SB(1, 1), b3 + hstep, voffB); PG8_STAGE(PG8_SA(1, 0), a3, s2[0]);
            PG8_WAIT_V(8); PG8_WAIT_L(0); PG8_BAR; PG8_MMA(1, 0, At, B0); PG8_MMA(1, 1, At, B1); PG8_BAR; PG8_SCHED;
        }
        if (wr == 0) PG8_BAR;
        if constexpr (FP8) asm volatile("s_nop 15\n\ts_nop 7" ::: "memory");
        if (!PG8_PROBE_NOEPI) E(acc, cur, wr, wc, fr, fq, PG8_EB(ui & 1), PG8_CB(ui & 1));
        if (!has_next) break;
#pragma unroll
        for (int a = 0; a < 2; ++a)
#pragma unroll
            for (int b = 0; b < 2; ++b)
#pragma unroll
                for (int m = 0; m < 4; ++m)
#pragma unroll
                    for (int n = 0; n < 2; ++n) acc[a][b][m][n] = (f32x4){0.f, 0.f, 0.f, 0.f};
        cur = nxt; cA = nA; cB = nB; ++ui;
#pragma unroll
        for (int h = 0; h < 2; ++h)
#pragma unroll
            for (int i = 0; i < 2; ++i) cv[h][i] = nv[h][i];
        if (wr == 1) PG8_BAR;
    }
    PG8_WAIT_V(0);
    PG8_BAR;
#undef PG8_EB
#undef PG8_CB
#undef PG8_SA
#undef PG8_SB
#undef PG8_STAGE
#undef PG8_LDA
#undef PG8_LDB
#undef PG8_MMA
#undef PG8_WAIT_V
#undef PG8_WAIT_L
#undef PG8_BAR
#undef PG8_SCHED
}
}

#define XB_TMO      128
#define XB_XCNT(j)  (256  + 64 * (j))
#define XB_XSUB(j)  (1280 + 64 * (j))
#define XB_XGEN(j)  (2304 + 64 * (j))
#define XB_TOP      3328
#define XB_TOPGEN   3392
#define XCD_BAR_WORDS 3456
#define XB_SPIN_CAP (1u << 18)
__device__ __forceinline__ unsigned xb_ld(unsigned* p)              { return __hip_atomic_load(p, __ATOMIC_RELAXED, __HIP_MEMORY_SCOPE_AGENT); }
__device__ __forceinline__ unsigned xb_add(unsigned* p, unsigned v) { return __hip_atomic_fetch_add(p, v, __ATOMIC_RELAXED, __HIP_MEMORY_SCOPE_AGENT); }
__device__ __forceinline__ unsigned xb_xcc_id() { return (unsigned)__builtin_amdgcn_s_getreg((3 << 11) | 20) & 0xFu; }
#define XB_SPIN(cond, bar) do { unsigned _sp = 0; while (cond) { __builtin_amdgcn_s_sleep(1); \
    if ((++_sp & 255u) == 0u) { if (xb_ld(&(bar)[XB_TMO])) break; if (_sp > XB_SPIN_CAP) { atomicAdd(&(bar)[XB_TMO], 1u); break; } } } } while (0)
struct XcdBarrier { unsigned* bar; unsigned x; volatile LAS unsigned* st; };
__device__ __forceinline__ XcdBarrier xcd_barrier_post(unsigned* bar, volatile LAS unsigned* st) {
    XcdBarrier b; b.bar = bar; b.x = xb_xcc_id(); b.st = st;
    if (threadIdx.x == 0) (void)xb_add(&bar[XB_XCNT(b.x)], 1u);
    return b;
}
__device__ __forceinline__ void xcd_barrier_complete(unsigned* bar, unsigned x, unsigned& nloc, unsigned& nx) {
    const unsigned G = gridDim.x * gridDim.y * gridDim.z;
    unsigned sum, cnt, mine, sp = 0u;
    for (;;) {
        sum = 0u; cnt = 0u; mine = 0u;
#pragma unroll
        for (unsigned j = 0; j < 16; ++j) { const unsigned c = xb_ld(&bar[XB_XCNT(j)]); sum += c; cnt += (c > 0u) ? 1u : 0u; mine = (j == x) ? c : mine; }
        if (sum == G) break;
        __builtin_amdgcn_s_sleep(1);
        if ((++sp & 255u) == 0u) { if (xb_ld(&bar[XB_TMO])) break; if (sp > XB_SPIN_CAP) { atomicAdd(&bar[XB_TMO], 1u); break; } }
    }
    nloc = mine > 0u ? mine : 1u; nx = cnt > 0u ? cnt : 1u;
}
__device__ __forceinline__ void xcd_barrier(const XcdBarrier& b) {
    asm volatile("s_waitcnt vmcnt(0)" ::: "memory");
    __syncthreads();
    if (threadIdx.x == 0) {
        unsigned* bar = b.bar;
        __builtin_amdgcn_s_waitcnt(0);
        unsigned nloc = b.st[0], nx = b.st[1];
        if (nloc == 0u) { xcd_barrier_complete(bar, b.x, nloc, nx); b.st[0] = nloc; b.st[1] = nx; }
        const unsigned old = xb_add(&bar[XB_XSUB(b.x)], 1u);
        const unsigned gen = old / nloc;
        if (old + 1u == (gen + 1u) * nloc) {
            __builtin_amdgcn_fence(__ATOMIC_RELEASE, "agent");
            asm volatile("s_waitcnt vmcnt(0)" ::: "memory");
            const unsigned og = xb_add(&bar[XB_TOP], 1u);
            const unsigned tg = og / nx;
            if (og + 1u == (tg + 1u) * nx) xb_add(&bar[XB_TOPGEN], 1u);
            else XB_SPIN(xb_ld(&bar[XB_TOPGEN]) == tg, bar);
            __builtin_amdgcn_fence(__ATOMIC_ACQUIRE, "agent");
            xb_add(&bar[XB_XGEN(b.x)], 1u);
            asm volatile("s_waitcnt vmcnt(0)" ::: "memory");
        } else {
            XB_SPIN(xb_ld(&bar[XB_XGEN(b.x)]) == gen, bar);
            __builtin_amdgcn_fence(__ATOMIC_ACQUIRE, "agent");
            asm volatile("s_waitcnt vmcnt(0)" ::: "memory");
        }
    }
    __syncthreads();
}

struct Args { const float* in[28]; float* out; unsigned char* ws; int ph_lo, ph_hi, krep, pad; };
struct Frame {
    LAS unsigned char* lds;
    const Args* a;
    int tid, lane, wave, vcu, G;
};
#define F_IN(i) (F.a->in[i])
#define F_x F_IN(0)
#define F_c F_IN(1)
#define F_w_ada F_IN(2)
#define F_b_ada F_IN(3)
#define F_g_norm1 F_IN(4)
#define F_w_in F_IN(5)
#define F_b_in F_IN(6)
#define F_g_q F_IN(7)
#define F_g_k F_IN(8)
#define F_sinks F_IN(9)
#define F_rel_bias F_IN(10)
#define F_w_dw F_IN(11)
#define F_b_dw F_IN(12)
#define F_ln_g F_IN(13)
#define F_ln_b F_IN(14)
#define F_g_out_attn F_IN(15)
#define F_g_out_conv F_IN(16)
#define F_w_out F_IN(17)
#define F_b_out F_IN(18)
#define F_g_norm2 F_IN(19)
#define F_w_router F_IN(20)
#define F_b_router F_IN(21)
#define F_w_gate F_IN(22)
#define F_b_gate F_IN(23)
#define F_w_up F_IN(24)
#define F_b_up F_IN(25)
#define F_w_down F_IN(26)
#define F_b_down F_IN(27)
#define F_out (F.a->out)
#define F_ws (F.a->ws)
#define F_ctl ((unsigned*)(F_ws + WS_CTL))
#define F_WinT ((bf16*)(F_ws + WS_WIN))
#define F_WoutT ((bf16*)(F_ws + WS_WOUT))
#define F_WguT ((unsigned char*)(F_ws + WS_WGU))
#define F_WdnT ((unsigned char*)(F_ws + WS_WDN))
#define F_h8 ((unsigned char*)(F_ws + WS_H8))
#define F_hb ((bf16*)(F_ws + WS_H))
#define F_qb ((bf16*)(F_ws + WS_Q))
#define F_kb ((bf16*)(F_ws + WS_K))
#define F_vb ((bf16*)(F_ws + WS_V))
#define F_glu ((bf16*)(F_ws + WS_GLU))
#define F_x1b ((bf16*)(F_ws + WS_H))
#define F_mix ((unsigned char*)(F_ws + WS_MIX))
#define F_act ((unsigned char*)(F_ws + WS_ACT))
#define F_part ((bf16*)(F_ws + WS_PART))
#define F_modf ((float*)(F_ctl + CW_MOD))
#define F_modp ((float*)(F_ws + WS_MISC + MS_MODP))
#define F_cvr ((float*)(F_ctl + CW_CVR))
#define F_cvgu ((float*)(F_ctl + CW_CVGU))
#define F_biasp ((float*)(F_ws + WS_MISC + MS_BIASP))
#define F_ra ((float*)(F_ws + WS_MISC + MS_RA))
#define F_topw ((float*)(F_ws + WS_MISC + MS_TOPW))
#define F_wr2 ((float*)(F_ws + WS_MISC + MS_WR2))
#define F_list ((u32x4*)(F_ws + WS_LIST))
__device__ __forceinline__ float modv(const Frame& F, int i) { return F_modf[i]; }
__device__ __forceinline__ f32x4 modv4(const Frame& F, int i) { return *(const f32x4*)(F_modf + i); }

__device__ __forceinline__ void ph0_mod(Frame& F) {
    const int gw = F.vcu * 8 + F.wave, NGW = F.G * 8;
    for (int it = gw; it < 32 * 48; it += NGW) {
        const int kc = it / 48, ng = it % 48, k0 = kc * 64, n0 = ng * 256 + 4 * F.lane;
        const float cvv = F_c[k0 + F.lane]; const float sv = cvv / (1.f + __expf(-cvv));
        f32x4 a = (f32x4){0.f, 0.f, 0.f, 0.f};
#pragma unroll 16
        for (int kk = 0; kk < 64; ++kk) { const float s = __shfl(sv, kk); const f32x4 w = __builtin_nontemporal_load((const f32x4*)(F_w_ada + (size_t)(k0 + kk) * (6 * D) + n0)); a += s * w; }
        *(f32x4*)(F_modp + (size_t)kc * (6 * D) + n0) = a;
    }
}

__device__ __forceinline__ void ph0b_modsum(Frame& F) {
    const int gt = (F.vcu * 8 + F.wave) * 64 + F.lane;
    if (gt < 6 * D / 4) { f32x4 a = *(const f32x4*)(F_b_ada + 4 * gt);
#pragma unroll 8
        for (int kc = 0; kc < 32; ++kc) a += *(const f32x4*)(F_modp + (size_t)kc * (6 * D) + 4 * gt);
        *(f32x4*)(F_modf + 4 * gt) = a; }
}

template <bool CV, bool FP8W>
__device__ __forceinline__ void tr_item(const Frame& F, const float* W, int N, void* WTv, int c0, int k0, int n0, LAS float* scr, int lane, float* cvdst, const float* bias) {
#pragma unroll 8
    for (int i = 0; i < 32; ++i) { const int kk = 2 * i + (lane >> 5); scr[kk * 33 + (lane & 31)] = __builtin_nontemporal_load(W + (size_t)(k0 + kk) * N + n0 + (lane & 31)); }
    if (CV) scr[64 * 33 + lane] = modv(F, 3 * D + k0 + lane);
    LDS_WAIT(); asm volatile("" ::: "memory");
    const int c = lane & 7;
#pragma unroll
    for (int j = 0; j < 4; ++j) { const int n = (lane >> 3) + 8 * j; const LAS float* s = scr + (8 * c) * 33 + n;
        if (FP8W) { u32x2 o; o.x = pk4_fp8(s[0 * 33] * W8_MUL, s[1 * 33] * W8_MUL, s[2 * 33] * W8_MUL, s[3 * 33] * W8_MUL); o.y = pk4_fp8(s[4 * 33] * W8_MUL, s[5 * 33] * W8_MUL, s[6 * 33] * W8_MUL, s[7 * 33] * W8_MUL);
            *(u32x2*)((unsigned char*)WTv + (size_t)(c0 + n) * D + k0 + 8 * c) = o; }
        else { u32x4 o; o.x = cvt_pk_bf16(s[0 * 33], s[1 * 33]); o.y = cvt_pk_bf16(s[2 * 33], s[3 * 33]); o.z = cvt_pk_bf16(s[4 * 33], s[5 * 33]); o.w = cvt_pk_bf16(s[6 * 33], s[7 * 33]);
            *(u32x4*)((bf16*)WTv + (size_t)(c0 + n) * D + k0 + 8 * c) = o; } }
    if (CV) {
        const int n = lane & 31, hf = lane >> 5; float s = 0.f;
#pragma unroll 8
        for (int kk = 0; kk < 32; ++kk) s += scr[64 * 33 + 32 * hf + kk] * scr[(32 * hf + kk) * 33 + n];
        s += __shfl_xor(s, 32);
        if (lane < 32) { if (k0 == 0) s += bias[n0 + n]; atomicAdd(cvdst + c0 + n, s); }
    }
    LDS_WAIT(); asm volatile("" ::: "memory");
}
__device__ __forceinline__ int win_dst(int n0) {
    if (n0 < 1280) { const int pn = n0 >> 8, rem = n0 & 255, wc = rem >> 6, bj = (rem & 63) >> 5; return 256 * pn + 128 * bj + 32 * wc; }
    const int n1 = n0 - 1280, bj = n1 >> 10, n2 = n1 & 1023, j = n2 >> 7, wc = (n2 & 127) >> 5; return 256 * (5 + j) + 128 * bj + 32 * wc;
}
__device__ __forceinline__ int win_src(int c) {
    const int pn = c >> 8, bj = (c >> 7) & 1, wc = (c >> 5) & 3, i = c & 31;
    if (pn < 5) return 256 * pn + 64 * wc + 32 * bj + i;
    return 1280 + 1024 * bj + 128 * (pn - 5) + 32 * wc + i;
}
__device__ __forceinline__ int down_row(int sc) { return (sc & ~255) + 128 * ((sc >> 3) & 1) + 32 * ((sc >> 6) & 3) + 8 * ((sc >> 4) & 3) + (sc & 7); }
template <bool CV>
__device__ __forceinline__ void tr_moe_item(const float* W, unsigned char* WT, int c0, int n0, LAS float* scr, const LAS float* shl, int lane, float* cvdst, const float* bias, int probe = 0) {
    const int lr0 = lane >> 3, lc0 = lane & 7;
    const unsigned long long wbase = (unsigned long long)W;
    const unsigned wlo = __builtin_amdgcn_readfirstlane((unsigned)wbase), whi = __builtin_amdgcn_readfirstlane((unsigned)(wbase >> 32));
    const __amdgpu_buffer_rsrc_t rs = __builtin_amdgcn_make_buffer_rsrc((void*)(((unsigned long long)whi << 32) | wlo), 0, D * D * 4, 0x00020000);
    const unsigned loff = (unsigned)(lr0 * D + 4 * lc0 + n0) * 4u;
#define TR_LOAD(rowk) __builtin_bit_cast(f32x4, __builtin_amdgcn_raw_buffer_load_b128(rs, loff, (unsigned)(rowk) * (unsigned)(D * 4), 2))
#ifdef PROBE_KREP
    const int pr_rowmul = (probe & 256) ? 32 : D, pr_kmul = (probe & 256) ? 0 : 1;
#else
    constexpr int pr_rowmul = D, pr_kmul = 1;
#endif
    f32x4 pre[2][16];
#pragma unroll
    for (int q = 0; q < 2; ++q)
#pragma unroll
        for (int i = 0; i < 16; ++i) pre[q][i] = TR_LOAD(128 * q + 8 * i);
    f32x2 cvs[4] = {{0.f, 0.f}, {0.f, 0.f}, {0.f, 0.f}, {0.f, 0.f}};
#pragma unroll 1
    for (int kp2 = 0; kp2 < 16; kp2 += 2) {
#pragma unroll
        for (int q = 0; q < 2; ++q) {
            const int kp = kp2 + q, kn = kp + 2 < 16 ? kp + 2 : 15;
            int lc = lc0, lr = lr0; asm volatile("" : "+v"(lc), "+v"(lr));
#pragma unroll
            for (int i = 0; i < 16; ++i) *(LAS f32x4*)(scr + (8 * i + lr) * 32 + 4 * ((lc + (i >> 1)) & 7)) = pre[q][i];
#pragma unroll
            for (int i = 0; i < 16; ++i) pre[q][i] = TR_LOAD(128 * kn + 8 * i);
            LDS_WAIT(); asm volatile("" ::: "memory");
            f32x2 shv[8];
            if (CV) {
#pragma unroll
                for (int t = 0; t < 8; ++t) shv[t] = *(const LAS f32x2*)(shl + 128 * kp + 16 * lc + 2 * t);
            }
#pragma unroll
            for (int j = 0; j < 4; ++j) {
                const LAS float* col = scr + (16 * lc) * 32 + ((lr + 8 * j + 4 * lc) & 31);
                f32x2 pv[8];
#pragma unroll
                for (int t = 0; t < 8; ++t) { f32x2 r; r.x = col[(2 * t) * 32]; r.y = col[(2 * t + 1) * 32]; pv[t] = r * W8_MUL; }
                if (CV) {
#pragma unroll
                    for (int t = 0; t < 8; ++t) cvs[j] += shv[t] * pv[t];
                }
                u32x4 o;
                o.x = pk_hi_lo_fp8(pv[0], pv[1]); o.y = pk_hi_lo_fp8(pv[2], pv[3]); o.z = pk_hi_lo_fp8(pv[4], pv[5]); o.w = pk_hi_lo_fp8(pv[6], pv[7]);
                const unsigned roffj = (unsigned)((CV ? c0 + lr + 8 * j : down_row(n0 + lr + 8 * j)) * pr_rowmul + 16 * lc * pr_kmul);
                __builtin_nontemporal_store(o, (u32x4*)(WT + roffj + (size_t)(128 * kp) * pr_kmul));
            }
            LDS_WAIT(); asm volatile("" ::: "memory");
        }
    }
#undef TR_LOAD
    if (CV) {
#pragma unroll
        for (int j = 0; j < 4; ++j) { float t = (cvs[j].x + cvs[j].y) * (1.0f / W8_MUL); t += __shfl_xor(t, 1); t += __shfl_xor(t, 2); t += __shfl_xor(t, 4); if (lc0 == 0) cvdst[c0 + lr0 + 8 * j] = t + bias[n0 + lr0 + 8 * j]; }
    }
}
__device__ __forceinline__ void moe_convert(Frame& F, int gw, int NGW, int probe = 0) {
    LAS float* scr = (LAS float*)(F.lds + F.wave * 16384);
    LAS float* shl = (LAS float*)(F.lds + 8 * 16384);
    const int lane = F.lane;
    for (int i = F.tid; i < D; i += 512) shl[i] = modv(F, 3 * D + i);
    __syncthreads();
    for (int it = gw; it < 3 * NE * 64; it += NGW) {
        const int nb = it & 63, e = (it >> 6) & 31, mat = it >> 11, n0 = 32 * nb;
#ifdef PROBE_KREP
        if (probe & 512) continue;
#endif
        if (mat == 2) tr_moe_item<false>(F_w_down + (size_t)e * D * D, F_WdnT + (size_t)e * D * D, n0, n0, scr, shl, lane, nullptr, nullptr, probe);
        else tr_moe_item<true>((mat ? F_w_up : F_w_gate) + (size_t)e * D * D, F_WguT + (size_t)e * 2 * D * D, 256 * (n0 >> 7) + 128 * mat + (n0 & 127), n0, scr, shl, lane, F_cvgu + e * 4096, (mat ? F_b_up : F_b_gate) + e * D, probe);
    }
    __syncthreads();
}
__device__ __forceinline__ void ph1_prologue(Frame& F) {
    LAS float* scr = (LAS float*)(F.lds + F.wave * 16384);
    const int gw = F.vcu * 8 + F.wave, NGW = F.G * 8, lane = F.lane;
    constexpr int I_IN = 32 * (DIN / 32), I_OUT = 32 * (D / 32);
    for (int it = gw; it < I_IN + I_OUT; it += NGW) {
        int r = it;
        if (r < I_IN) { const int nb = r % (DIN / 32), kb = r / (DIN / 32); tr_item<false, false>(F, F_w_in, DIN, F_WinT, win_dst(32 * nb), 64 * kb, 32 * nb, scr, lane, nullptr, nullptr); continue; } r -= I_IN;
        { const int nb = r % 64, kb = r / 64; tr_item<false, true>(F, F_w_out, D, F_WoutT, 32 * nb, 64 * kb, 32 * nb, scr, lane, nullptr, nullptr); }
    }
    {
        f32x4 ga[8], sh[8];
#pragma unroll
        for (int j = 0; j < 8; ++j) { const int cidx = 4 * lane + 256 * j; ga[j] = *(const f32x4*)(F_g_norm1 + cidx) * (modv4(F, D + cidx) + 1.0f); sh[j] = modv4(F, cidx); }
        for (int m = gw; m < T; m += NGW) {
            const f32x4* xr = (const f32x4*)(F_x + (size_t)m * D) + lane; f32x4 v[8]; float s = 0.f;
#pragma unroll
            for (int j = 0; j < 8; ++j) { v[j] = __builtin_nontemporal_load(xr + 64 * j); s += (v[j].x * v[j].x + v[j].y * v[j].y) + (v[j].z * v[j].z + v[j].w * v[j].w); }
            const float rn = __builtin_amdgcn_rsqf(wave_sum(s) * (1.f / D) + EPS);
            u32x2* o = (u32x2*)(F_hb + (size_t)m * D) + lane;
#pragma unroll
            for (int j = 0; j < 8; ++j) { const f32x4 y = v[j] * rn * ga[j] + sh[j]; u32x2 w; w.x = cvt_pk_bf16(y.x, y.y); w.y = cvt_pk_bf16(y.z, y.w); o[64 * j] = w; }
        }
    }
    const int gt = (F.vcu * 8 + F.wave) * 64 + lane, NGT = NGW * 64;
    for (int i = gt; i < DIN; i += NGT) F_biasp[i] = F_b_in[win_src(i)];
    for (int i = gt; i < D * NE; i += NGT) { const int k = i >> 5; F_wr2[i] = F_g_norm2[k] * (1.f + modv(F, 4 * D + k)) * F_w_router[i]; }
    if (gw < NE) { float s = 0.f; for (int k = lane; k < D; k += 64) s += modv(F, 3 * D + k) * F_w_router[k * NE + gw]; s = wave_sum(s); if (lane == 0) F_cvr[gw] = s + F_b_router[gw]; }
}

struct EpiInProj {
    static constexpr bool PERM = true;
    bf16 *q, *k, *v, *glu; const float *biasp, *gq, *gk;
    __device__ __forceinline__ void operator()(const f32x4 (&acc)[2][2][4][2], const pg8::Unit& u, int wr, int wc, int fr, int fq, const LAS unsigned char* eb, const LAS unsigned char* cbuf) const {
        asm volatile("" : "+v"(fr), "+v"(fq));
        const int row0 = u.pm * 256 + wr * 64 + fr, cb = u.pn * 256 + wc * 32 + 8 * fq;
        f32x4 bv[2][2];
#pragma unroll
        for (int bj = 0; bj < 2; ++bj)
#pragma unroll
            for (int n = 0; n < 2; ++n) bv[bj][n] = *(const f32x4*)(biasp + cb + 128 * bj + 4 * n);
        if (u.pn < 5) {
            const bool isq = u.pn < 4, isk = (u.pn == 4) && (wc < 2), nrm = isq || isk;
            bf16* base = isq ? q : (isk ? k : v); const int ld = isq ? DA : DKV; const int hcol = isq ? (4 * u.pn + wc) * 64 : (isk ? wc * 64 : (wc - 2) * 64);
            const float* gp = isq ? gq : gk; const float sc = isq ? QSCALE : 1.0f;
            f32x4 gv[2][2];
#pragma unroll
            for (int bj = 0; bj < 2; ++bj)
#pragma unroll
                for (int n = 0; n < 2; ++n) gv[bj][n] = nrm ? *(const f32x4*)(gp + 32 * bj + 8 * fq + 4 * n) * sc : (f32x4){1.f, 1.f, 1.f, 1.f};
#pragma unroll
            for (int ai = 0; ai < 2; ++ai)
#pragma unroll
                for (int m = 0; m < 4; ++m) {
                    f32x4 xv[2][2]; float ss = 0.f;
#pragma unroll
                    for (int bj = 0; bj < 2; ++bj)
#pragma unroll
                        for (int n = 0; n < 2; ++n) { xv[bj][n] = acc[ai][bj][m][n] + bv[bj][n]; const f32x4 t = xv[bj][n]; ss += (t.x * t.x + t.y * t.y) + (t.z * t.z + t.w * t.w); }
                    ss += __shfl_xor(ss, 16); ss += __shfl_xor(ss, 32);
                    const float rn = nrm ? __builtin_amdgcn_rsqf(ss * (1.f / 64.f) + EPS) : 1.0f;
                    bf16* rowp = base + (size_t)(row0 + 128 * ai + 16 * m) * ld + hcol + 8 * fq;
#pragma unroll
                    for (int bj = 0; bj < 2; ++bj) { const f32x4 a = xv[bj][0] * rn * gv[bj][0], b = xv[bj][1] * rn * gv[bj][1];
                        u32x4 w; w.x = cvt_pk_bf16(a.x, a.y); w.y = cvt_pk_bf16(a.z, a.w); w.z = cvt_pk_bf16(b.x, b.y); w.w = cvt_pk_bf16(b.z, b.w);
                        *(u32x4*)(rowp + 32 * bj) = w; }
                }
        } else {
            const int ccol = 128 * (u.pn - 5) + 32 * wc + 8 * fq;
#pragma unroll
            for (int ai = 0; ai < 2; ++ai)
#pragma unroll
                for (int m = 0; m < 4; ++m) {
                    float o[8];
#pragma unroll
                    for (int n = 0; n < 2; ++n) { const f32x4 a = acc[ai][0][m][n] + bv[0][n], g = acc[ai][1][m][n] + bv[1][n];
#pragma unroll
                        for (int j = 0; j < 4; ++j) o[4 * n + j] = a[j] * __builtin_amdgcn_rcpf(1.f + __builtin_amdgcn_exp2f(-LOG2E * g[j])); }
                    u32x4 w; w.x = cvt_pk_bf16(o[0], o[1]); w.y = cvt_pk_bf16(o[2], o[3]); w.z = cvt_pk_bf16(o[4], o[5]); w.w = cvt_pk_bf16(o[6], o[7]);
                    *(u32x4*)(glu + (size_t)(row0 + 128 * ai + 16 * m) * DC + ccol) = w;
                }
        }
    }
};
struct EpiOut {
    static constexpr bool PERM = true;
    const float *x, *ra, *modf, *b_out; bf16* out;
    __device__ __forceinline__ void operator()(const f32x4 (&acc)[2][2][4][2], const pg8::Unit& u, int wr, int wc, int fr, int fq, const LAS unsigned char* eb, const LAS unsigned char* cbuf) const {
        asm volatile("" : "+v"(fr), "+v"(fq));
        const int row0 = u.pm * 256 + wr * 64 + fr, col0 = u.pn * 256 + wc * 32 + 8 * fq;
        f32x4 g1[2][2], bo[2][2];
#pragma unroll
        for (int bj = 0; bj < 2; ++bj)
#pragma unroll
            for (int n = 0; n < 2; ++n) { const int c = col0 + 128 * bj + 4 * n; g1[bj][n] = *(const f32x4*)(modf + 2 * D + c); bo[bj][n] = *(const f32x4*)(b_out + c); }
#pragma unroll
        for (int ai = 0; ai < 2; ++ai)
#pragma unroll
            for (int mp = 0; mp < 2; ++mp) {
                f32x4 xv[2][2][2]; float rs[2];
#pragma unroll
                for (int mm = 0; mm < 2; ++mm) { const int r = row0 + 128 * ai + 16 * (2 * mp + mm); rs[mm] = ra[r]; const size_t off = (size_t)r * D + col0;
#pragma unroll
                    for (int bj = 0; bj < 2; ++bj)
#pragma unroll
                        for (int n = 0; n < 2; ++n) xv[mm][bj][n] = __builtin_nontemporal_load((const f32x4*)(x + off + 128 * bj + 4 * n)); }
#pragma unroll
                for (int mm = 0; mm < 2; ++mm) { const int m = 2 * mp + mm; const size_t off = (size_t)(row0 + 128 * ai + 16 * m) * D + col0;
#pragma unroll
                    for (int bj = 0; bj < 2; ++bj) { const f32x4 v0 = xv[mm][bj][0] + g1[bj][0] * (acc[ai][bj][m][0] * rs[mm] + bo[bj][0]), v1 = xv[mm][bj][1] + g1[bj][1] * (acc[ai][bj][m][1] * rs[mm] + bo[bj][1]);
                        u32x4 w; w.x = cvt_pk_bf16(v0.x, v0.y); w.y = cvt_pk_bf16(v0.z, v0.w); w.z = cvt_pk_bf16(v1.x, v1.y); w.w = cvt_pk_bf16(v1.z, v1.w);
                        *(u32x4*)(out + off + 128 * bj) = w; } }
                asm volatile("" ::: "memory");
            }
    }
};
struct EpiGU {
    static constexpr bool PERM = true;
    unsigned char* act;
    __device__ __forceinline__ void operator()(const f32x4 (&acc)[2][2][4][2], const pg8::Unit& u, int wr, int wc, int fr, int fq, const LAS unsigned char* eb, const LAS unsigned char* cbuf) const {
        asm volatile("" : "+v"(fr), "+v"(fq));
        const int lrow0 = wr * 64 + fr; const LAS float* cvp = (const LAS float*)cbuf + wc * 32 + 8 * fq;
        f32x4 cg[2], cu[2];
#pragma unroll
        for (int n = 0; n < 2; ++n) { cg[n] = *(const LAS f32x4*)(cvp + 4 * n); cu[n] = *(const LAS f32x4*)(cvp + 128 + 4 * n); }
        float rsv[2][4];
#pragma unroll
        for (int ai = 0; ai < 2; ++ai)
#pragma unroll
            for (int m = 0; m < 4; ++m) rsv[ai][m] = *(const LAS float*)(eb + (lrow0 + 128 * ai + 16 * m) * 16 + 4);
#pragma unroll
        for (int ai = 0; ai < 2; ++ai)
#pragma unroll
            for (int m = 0; m < 4; ++m) { const int lr = lrow0 + 128 * ai + 16 * m; const float rs = lr < u.nv ? rsv[ai][m] : 0.f;
                float o[8];
#pragma unroll
                for (int n = 0; n < 2; ++n) { const f32x4 g = acc[ai][0][m][n] * rs + cg[n], l = acc[ai][1][m][n] * rs + cu[n];
#pragma unroll
                    for (int j = 0; j < 4; ++j) { const float gg = fminf(g[j], 7.0f), ll = fminf(fmaxf(l[j], -7.0f), 7.0f);
                        o[4 * n + j] = gg * __builtin_amdgcn_rcpf(1.f + __builtin_amdgcn_exp2f(-1.702f * LOG2E * gg)) * (ll + 1.0f); } }
                u32x2 w; w.x = pk4_fp8(o[0], o[1], o[2], o[3]); w.y = pk4_fp8(o[4], o[5], o[6], o[7]);
                *(u32x2*)(act + (size_t)(u.pm * 256 + lr) * D + 128 * u.pn + 32 * wc + 8 * fq) = w; }
    }
};
struct EpiDown {
    static constexpr bool PERM = true;
    bf16* part;
    __device__ __forceinline__ void operator()(const f32x4 (&acc)[2][2][4][2], const pg8::Unit& u, int wr, int wc, int fr, int fq, const LAS unsigned char* eb, const LAS unsigned char* cbuf) const {
        asm volatile("" : "+v"(fr), "+v"(fq));
        const int lrow0 = wr * 64 + fr, col0 = u.pn * 256 + wc * 64 + 16 * fq;
        f32x4 bd[2][2];
#pragma unroll
        for (int bj = 0; bj < 2; ++bj)
#pragma unroll
            for (int n = 0; n < 2; ++n) bd[bj][n] = *(const LAS f32x4*)((const LAS float*)cbuf + wc * 64 + 16 * fq + 8 * bj + 4 * n);
        unsigned tsv[2][4]; float wsv[2][4];
#pragma unroll
        for (int ai = 0; ai < 2; ++ai)
#pragma unroll
            for (int m = 0; m < 4; ++m) { const u32x2 en = *(const LAS u32x2*)(eb + (lrow0 + 128 * ai + 16 * m) * 16); const unsigned wb = *(const LAS unsigned*)(eb + (lrow0 + 128 * ai + 16 * m) * 16 + 8); tsv[ai][m] = en.x; wsv[ai][m] = __uint_as_float(wb); }
#pragma unroll
        for (int ai = 0; ai < 2; ++ai)
#pragma unroll
            for (int m = 0; m < 4; ++m) { const int lr = lrow0 + 128 * ai + 16 * m;
                if (lr < u.nv) { const unsigned ts = tsv[ai][m]; const float w8 = wsv[ai][m];
                    bf16* rowp = part + ((size_t)(ts & 3) * T + (ts >> 2)) * D + col0;
#pragma unroll
                    for (int bj = 0; bj < 2; ++bj) { const f32x4 a = (acc[ai][bj][m][0] + bd[bj][0]) * w8, b = (acc[ai][bj][m][1] + bd[bj][1]) * w8;
                        u32x4 w; w.x = cvt_pk_bf16(a.x, a.y); w.y = cvt_pk_bf16(a.z, a.w); w.z = cvt_pk_bf16(b.x, b.y); w.w = cvt_pk_bf16(b.z, b.w);
                        *(u32x4*)(rowp + 8 * bj) = w; } } }
    }
};

template <int I> struct ConvStep {
    static __device__ __forceinline__ void run(f32x2 (&o)[32], const f32x2 (&wv)[31], const bf16* glu, int rb, int c0) {
        const int row = rb - 30 + I; const int rc = row < 0 ? 0 : row; unsigned v = *(const unsigned*)(glu + (size_t)rc * DC + c0); v = row < 0 ? 0u : v;
        f32x2 xv; xv.x = bf_lo(v); xv.y = bf_hi(v);
#pragma unroll
        for (int j = 0; j < 31; ++j) { const int r = I - j; if (r >= 0 && r < 32) o[r] += wv[j] * xv; }
        ConvStep<I + 1>::run(o, wv, glu, rb, c0);
    }
};
template <> struct ConvStep<62> { static __device__ __forceinline__ void run(f32x2 (&)[32], const f32x2 (&)[31], const bf16*, int, int) {} };
__device__ __forceinline__ s16x4 vtr(const LAS unsigned char* p) { typedef short v4i16_t __attribute__((ext_vector_type(4))); return __builtin_bit_cast(s16x4, __builtin_amdgcn_ds_read_tr16_b64_v4i16((LAS v4i16_t*)p)); }
__device__ __forceinline__ void ph3_unit(Frame& F, int u, int probe = 0) {
    LAS unsigned char* L = F.lds;
    LAS unsigned char* Kl = L + P3_K; LAS unsigned char* Vl = L + P3_V; LAS float* tab = (LAS float*)(L + P3_TAB);
    LAS float* SSQ = (LAS float*)(L + P3_SSQ); LAS float* RA = (LAS float*)(L + P3_RA);
    const int tid = F.tid, lane = F.lane, w = F.wave, i16 = lane & 15, g4 = lane >> 4;
    const int q0 = u * 64, kbase = q0 - 128;
    for (int idx = tid; idx < 3072; idx += 512) { const int row = idx >> 4, ch = idx & 15, key = kbase + row; u32x4 kv = (u32x4){0u, 0u, 0u, 0u}, vv = kv;
        if (key >= 0) { kv = *(const u32x4*)(F_kb + (size_t)key * DKV + ch * 8); vv = *(const u32x4*)(F_vb + (size_t)key * DKV + ch * 8); }
        *(LAS u32x4*)(Kl + row * 288 + ch * 16) = kv; *(LAS u32x4*)(Vl + row * 288 + ch * 16) = vv; }
    for (int idx = tid; idx < 2048; idx += 512) { const int h = idx >> 7, d = idx & 127; int b = d;
        if (d >= 16) { b = 16 + (int)(logf((float)d * (1.f / 16.f)) / 2.0794415416798357f * 16.f); b = b > 31 ? 31 : b; }
        tab[idx] = F_rel_bias[b * NH + h] * LOG2E; }
    __syncthreads();
    bf16x8 nq0 = *(const bf16x8*)(F_qb + (size_t)(q0 + i16) * DA + w * 64 + 8 * g4), nq1 = *(const bf16x8*)(F_qb + (size_t)(q0 + i16) * DA + w * 64 + 32 + 8 * g4);
#pragma unroll 1
    for (int it = 0; it < 8; ++it) {
#ifdef PROBE_KREP
        if (probe & 256) break;
#endif
        const int hh = it >> 2, c = it & 3, h = w + 8 * hh; const float sink2 = F_sinks[h] * LOG2E;
        {
            const int t0 = c > 0 ? c - 1 : 0, qrow = q0 + 16 * c + i16;
            const bf16x8 qf0 = nq0, qf1 = nq1;
            { const int itn = it < 7 ? it + 1 : 7, hn = w + 8 * (itn >> 2), qn = q0 + 16 * (itn & 3) + i16;
              nq0 = *(const bf16x8*)(F_qb + (size_t)qn * DA + hn * 64 + 8 * g4); nq1 = *(const bf16x8*)(F_qb + (size_t)qn * DA + hn * 64 + 32 + 8 * g4); }
            f32x4 ga[4];
#pragma unroll
            for (int dt = 0; dt < 4; ++dt) ga[dt] = *(const f32x4*)(F_g_out_attn + h * 64 + 16 * dt + 4 * g4);
            f32x4 s[10];
#pragma unroll
            for (int tt = 0; tt < 10; ++tt) { const LAS unsigned char* kp = Kl + (16 * (t0 + tt) + i16) * 288 + (hh * 64 + 8 * g4) * 2;
                const bf16x8 k0 = *(const LAS bf16x8*)kp, k1 = *(const LAS bf16x8*)(kp + 64); f32x4 a = (f32x4){0.f, 0.f, 0.f, 0.f};
                a = __builtin_amdgcn_mfma_f32_16x16x32_bf16(k0, qf0, a, 0, 0, 0); a = __builtin_amdgcn_mfma_f32_16x16x32_bf16(k1, qf1, a, 0, 0, 0); s[tt] = a; }
            float mx = -1e30f;
#pragma unroll
            for (int tt = 0; tt < 10; ++tt)
#pragma unroll
                for (int r = 0; r < 4; ++r) { const int kk = 16 * (t0 + tt) + 4 * g4 + r, dist = 128 + 16 * c + i16 - kk; const bool valid = (dist >= 0) && (dist < 128) && (kbase + kk >= 0);
                    const float bb = tab[h * 128 + (valid ? dist : 0)]; const float sv = valid ? s[tt][r] + bb : -1e30f; s[tt][r] = sv; mx = fmaxf(mx, sv); }
            mx = fmaxf(mx, __shfl_xor(mx, 16)); mx = fmaxf(mx, __shfl_xor(mx, 32)); mx = fmaxf(mx, sink2);
            float l = 0.f;
#pragma unroll
            for (int tt = 0; tt < 10; ++tt)
#pragma unroll
                for (int r = 0; r < 4; ++r) { const float p = __builtin_amdgcn_exp2f(s[tt][r] - mx); s[tt][r] = p; l += p; }
            l += __shfl_xor(l, 16); l += __shfl_xor(l, 32);
            const float inv = 1.0f / (l + __builtin_amdgcn_exp2f(sink2 - mx));
            bf16x8 pf[5];
#pragma unroll
            for (int ks = 0; ks < 5; ++ks) { u32x4 w; w.x = cvt_pk_bf16(s[2 * ks][0], s[2 * ks][1]); w.y = cvt_pk_bf16(s[2 * ks][2], s[2 * ks][3]); w.z = cvt_pk_bf16(s[2 * ks + 1][0], s[2 * ks + 1][1]); w.w = cvt_pk_bf16(s[2 * ks + 1][2], s[2 * ks + 1][3]);
                pf[ks] = __builtin_bit_cast(bf16x8, w); }
            float ssq = 0.f;
#pragma unroll
            for (int dt = 0; dt < 4; ++dt) { f32x4 o = (f32x4){0.f, 0.f, 0.f, 0.f};
#pragma unroll
                for (int ks = 0; ks < 5; ++ks) { const LAS unsigned char* vp = Vl + (16 * (t0 + 2 * ks) + 4 * g4 + (i16 >> 2)) * 288 + (hh * 64 + 16 * dt + 4 * (i16 & 3)) * 2;
                    const s16x4 lo = vtr(vp), hi = vtr(vp + 16 * 288); bf16x8 vf; vf[0] = lo[0]; vf[1] = lo[1]; vf[2] = lo[2]; vf[3] = lo[3]; vf[4] = hi[0]; vf[5] = hi[1]; vf[6] = hi[2]; vf[7] = hi[3];
                    o = __builtin_amdgcn_mfma_f32_16x16x32_bf16(vf, pf[ks], o, 0, 0, 0); }
                o = o * inv; ssq += (o.x * o.x + o.y * o.y) + (o.z * o.z + o.w * o.w); o = o * ga[dt];
                *(unsigned*)(F_mix + (size_t)qrow * D + h * 64 + 16 * dt + 4 * g4) = pk4_fp8(o.x, o.y, o.z, o.w); }
            ssq += __shfl_xor(ssq, 16); ssq += __shfl_xor(ssq, 32);
            if (g4 == 0) SSQ[(hh * 8 + w) * 64 + 16 * c + i16] = ssq;
        }
    }
    __syncthreads();
    if (tid < 64) { float s = 0.f;
#pragma unroll
        for (int j = 0; j < 16; ++j) s += SSQ[j * 64 + tid];
        const float r = __builtin_amdgcn_rsqf(s * (1.f / DA) + EPS); RA[tid] = r; F_ra[q0 + tid] = r; }
    __syncthreads();
#ifdef PROBE_KREP
    if (probe & 512) return;
#endif
    LAS float* CT = (LAS float*)L;
    const int c0 = 2 * tid;
    f32x2 wv[31];
    { const float* wdw = F_w_dw + c0; asm volatile("" : "+v"(wdw));
#pragma unroll
    for (int j = 0; j < 31; ++j) wv[j] = *(const f32x2*)(wdw + j * DC); }
    const f32x2 bdw = *(const f32x2*)(F_b_dw + c0);
#pragma unroll 1
    for (int p = 0; p < 2; ++p) {
        const int rb = q0 + 32 * p;
        f32x2 o[32];
#pragma unroll
        for (int r = 0; r < 32; ++r) o[r] = bdw;
        ConvStep<0>::run(o, wv, F_glu, rb, c0);
#pragma unroll
        for (int r = 0; r < 32; ++r) *(LAS f32x2*)(CT + r * P3_CTP + c0) = o[r];
        __syncthreads();
#pragma unroll 1
        for (int rr = 0; rr < 4; ++rr) { const int r = 4 * w + rr, row = rb + r;
            f32x4 v[4]; float s1 = 0.f;
#pragma unroll
            for (int jj = 0; jj < 4; ++jj) { v[jj] = *(const LAS f32x4*)(CT + r * P3_CTP + 4 * lane + 256 * jj); s1 += (v[jj].x + v[jj].y) + (v[jj].z + v[jj].w); }
            const float mean = wave_sum(s1) * (1.f / DC); float s2 = 0.f;
#pragma unroll
            for (int jj = 0; jj < 4; ++jj) { v[jj] = v[jj] - mean; s2 += (v[jj].x * v[jj].x + v[jj].y * v[jj].y) + (v[jj].z * v[jj].z + v[jj].w * v[jj].w); }
            const float rstd = __builtin_amdgcn_rsqf(wave_sum(s2) * (1.f / DC) + EPS); float s3 = 0.f;
#pragma unroll
            for (int jj = 0; jj < 4; ++jj) { const int cc = 4 * lane + 256 * jj; const f32x4 y = v[jj] * rstd * *(const f32x4*)(F_ln_g + cc) + *(const f32x4*)(F_ln_b + cc); f32x4 z;
#pragma unroll
                for (int j = 0; j < 4; ++j) z[j] = y[j] * __builtin_amdgcn_rcpf(1.f + __builtin_amdgcn_exp2f(-LOG2E * y[j]));
                v[jj] = z; s3 += (z.x * z.x + z.y * z.y) + (z.z * z.z + z.w * z.w); }
            const float fac = __builtin_amdgcn_rsqf(wave_sum(s3) * (1.f / DC) + EPS) / RA[32 * p + r];
#pragma unroll
            for (int jj = 0; jj < 4; ++jj) { const int cc = 4 * lane + 256 * jj; const f32x4 z = v[jj] * fac * *(const f32x4*)(F_g_out_conv + cc);
                *(unsigned*)(F_mix + (size_t)row * D + DA + cc) = pk4_fp8(z.x, z.y, z.z, z.w); }
        }
        __syncthreads();
    }
}

__device__ __forceinline__ void ph5_iter(Frame& F, int it) {
    LAS float* P = (LAS float*)F.lds;
    LAS float* SS = P + 8 * 64 * 32;
    LAS int* LC = (LAS int*)(SS + 512);
    const int tid = F.tid, lane = F.lane, w = F.wave, i16 = lane & 15, g4 = lane >> 4, rb = 64 * it;
    if (tid < 64) LC[tid] = 0;
    f32x4 acc[4][2]; float ssl[4];
#pragma unroll
    for (int t = 0; t < 4; ++t) { acc[t][0] = (f32x4){0.f, 0.f, 0.f, 0.f}; acc[t][1] = acc[t][0]; ssl[t] = 0.f; }
#pragma unroll 1
    for (int blk = 0; blk < 4; ++blk) {
        const int kb = 256 * w + 64 * blk + 16 * g4;
        f32x4 gv[4];
#pragma unroll
        for (int jj = 0; jj < 4; ++jj) gv[jj] = *(const f32x4*)(F_g_norm2 + kb + 4 * jj) * (modv4(F, 4 * D + kb + 4 * jj) + 1.0f);
        f32x4 xv[4][4];
#pragma unroll
        for (int t = 0; t < 4; ++t)
#pragma unroll
            for (int jj = 0; jj < 4; jj += 2) { const u32x4 pv = *(const u32x4*)(F_x1b + (size_t)(rb + 16 * t + i16) * D + kb + 4 * jj);
                xv[t][jj] = (f32x4){bf_lo(pv.x), bf_hi(pv.x), bf_lo(pv.y), bf_hi(pv.y)}; xv[t][jj + 1] = (f32x4){bf_lo(pv.z), bf_hi(pv.z), bf_lo(pv.w), bf_hi(pv.w)}; }
#pragma unroll
        for (int t = 0; t < 4; ++t) { u32x4 w0; f32x4 y[4];
#pragma unroll
            for (int jj = 0; jj < 4; ++jj) { const f32x4 xx = xv[t][jj]; ssl[t] += (xx.x * xx.x + xx.y * xx.y) + (xx.z * xx.z + xx.w * xx.w); y[jj] = xx * gv[jj]; }
            w0.x = pk4_fp8(y[0].x, y[0].y, y[0].z, y[0].w); w0.y = pk4_fp8(y[1].x, y[1].y, y[1].z, y[1].w); w0.z = pk4_fp8(y[2].x, y[2].y, y[2].z, y[2].w); w0.w = pk4_fp8(y[3].x, y[3].y, y[3].z, y[3].w);
            *(u32x4*)(F_h8 + (size_t)(rb + 16 * t + i16) * D + kb) = w0; }
#pragma unroll
        for (int s = 0; s < 16; ++s) { const float b0 = F_wr2[(kb + s) * NE + i16], b1 = F_wr2[(kb + s) * NE + 16 + i16];
#pragma unroll
            for (int t = 0; t < 4; ++t) { const float a = xv[t][s >> 2][s & 3];
                acc[t][0] = __builtin_amdgcn_mfma_f32_16x16x4f32(a, b0, acc[t][0], 0, 0, 0); acc[t][1] = __builtin_amdgcn_mfma_f32_16x16x4f32(a, b1, acc[t][1], 0, 0, 0); } }
    }
    int i16b = i16, g4b = g4; asm volatile("" : "+v"(i16b), "+v"(g4b));
#pragma unroll
    for (int t = 0; t < 4; ++t) {
#pragma unroll
        for (int hf = 0; hf < 2; ++hf)
#pragma unroll
            for (int r = 0; r < 4; ++r) P[(w * 64 + 16 * t + 4 * g4b + r) * 32 + 16 * hf + i16b] = acc[t][hf][r];
        float v = ssl[t]; v += __shfl_xor(v, 16); v += __shfl_xor(v, 32); if (g4b == 0) SS[w * 64 + 16 * t + i16b] = v; }
    __syncthreads();
    int ek[4] = {0, 0, 0, 0}; int lr[4] = {0, 0, 0, 0}; float wk[4] = {0.f, 0.f, 0.f, 0.f}; float rr = 0.f; const int tok = rb + tid;
    if (tid < 64) {
        float lg[32]; float ssum = 0.f; int tidb = tid; asm volatile("" : "+v"(tidb));
#pragma unroll
        for (int e = 0; e < 32; ++e) lg[e] = 0.f;
#pragma unroll
        for (int ww = 0; ww < 8; ++ww) { ssum += SS[ww * 64 + tidb];
#pragma unroll
            for (int e4 = 0; e4 < 8; ++e4) { const f32x4 t4 = *(const LAS f32x4*)(P + (ww * 64 + tidb) * 32 + 4 * e4); lg[4 * e4] += t4.x; lg[4 * e4 + 1] += t4.y; lg[4 * e4 + 2] += t4.z; lg[4 * e4 + 3] += t4.w; } }
        rr = __builtin_amdgcn_rsqf(ssum * (1.f / D) + EPS);
#pragma unroll
        for (int e = 0; e < 32; ++e) lg[e] = lg[e] * rr + F_cvr[e];
        float vk[4];
#pragma unroll
        for (int k = 0; k < 4; ++k) { float best = -3.0e38f; int bi = 0;
#pragma unroll
            for (int e = 0; e < 32; ++e) { bool ok = lg[e] > best;
#pragma unroll
                for (int p = 0; p < 4; ++p) if (p < k) ok = ok && (ek[p] != e);
                best = ok ? lg[e] : best; bi = ok ? e : bi; }
            ek[k] = bi; vk[k] = best; }
        const float e1 = __expf(vk[1] - vk[0]), e2 = __expf(vk[2] - vk[0]), e3 = __expf(vk[3] - vk[0]); const float inv = 1.0f / (1.0f + e1 + e2 + e3);
        wk[0] = inv; wk[1] = e1 * inv; wk[2] = e2 * inv; wk[3] = e3 * inv;
#pragma unroll
        for (int k = 0; k < 4; ++k) lr[k] = __hip_atomic_fetch_add(LC + ek[k], 1, __ATOMIC_RELAXED, __HIP_MEMORY_SCOPE_WORKGROUP);
    }
    __syncthreads();
    if (tid < 32) { const int n = LC[tid]; int base = 0; if (n > 0) base = (int)__hip_atomic_fetch_add(F_ctl + CW_CNT + 64 * tid, (unsigned)n, RLX_AGENT); LC[32 + tid] = base; }
    __syncthreads();
    if (tid < 64) {
#pragma unroll
        for (int k = 0; k < 4; ++k) { const int pos = LC[32 + ek[k]] + lr[k]; u32x4 en; en.x = (unsigned)(tok * 4 + k); en.y = __float_as_uint(rr); en.z = __float_as_uint(wk[k]); en.w = 0u; F_list[(size_t)ek[k] * LCAP + pos] = en; }
    }
    __syncthreads();
}

__device__ __forceinline__ int moe_tables(Frame& F, int npn) {
    LAS int* tab = (LAS int*)(F.lds + MISC_OFF + 64);
    __syncthreads();
    if (F.tid < 32) tab[F.tid] = (int)__hip_atomic_load(F_ctl + CW_CNT + 64 * F.tid, RLX_AGENT);
    __syncthreads();
    if (F.tid == 0) { int pu = 0, pt = 0; for (int e = 0; e < 32; ++e) { tab[32 + e] = pu; tab[65 + e] = pt; const int nt = (tab[e] + 255) >> 8; pu += nt * npn; pt += nt; } tab[64] = pu; tab[97] = pt; }
    __syncthreads();
    return __builtin_amdgcn_readfirstlane(tab[64]);
}

__device__ __forceinline__ void ph8_final(Frame& F) {
    const int gw = F.vcu * 8 + F.wave, NGW = F.G * 8, lane = F.lane;
    f32x4 g2[4][2];
#pragma unroll
    for (int jj = 0; jj < 4; ++jj)
#pragma unroll
        for (int q = 0; q < 2; ++q) g2[jj][q] = modv4(F, 5 * D + 8 * lane + 512 * jj + 4 * q);
    for (int row = gw; row < T; row += NGW) {
#pragma unroll
        for (int jj = 0; jj < 4; ++jj) { const int col = 8 * lane + 512 * jj; float* op = F_out + (size_t)row * D + col;
            f32x4 a0 = (f32x4){0.f, 0.f, 0.f, 0.f}, a1 = a0;
#pragma unroll
            for (int s = 0; s < 4; ++s) { const u32x4 pv = __builtin_nontemporal_load((const u32x4*)(F_part + ((size_t)s * T + row) * D + col));
                a0 += (f32x4){bf_lo(pv.x), bf_hi(pv.x), bf_lo(pv.y), bf_hi(pv.y)}; a1 += (f32x4){bf_lo(pv.z), bf_hi(pv.z), bf_lo(pv.w), bf_hi(pv.w)}; }
            const u32x4 xb = __builtin_nontemporal_load((const u32x4*)(F_x1b + (size_t)row * D + col));
            const f32x4 x0 = (f32x4){bf_lo(xb.x), bf_hi(xb.x), bf_lo(xb.y), bf_hi(xb.y)}, x1 = (f32x4){bf_lo(xb.z), bf_hi(xb.z), bf_lo(xb.w), bf_hi(xb.w)};
            __builtin_nontemporal_store(x0 + g2[jj][0] * a0, (f32x4*)op); __builtin_nontemporal_store(x1 + g2[jj][1] * a1, (f32x4*)(op + 4)); }
    }
}

__global__ void __launch_bounds__(512, 2) fwd_kernel(Args args) {
    extern __shared__ __attribute__((aligned(16))) unsigned char lds[];
    Frame F;
    F.lds = (LAS unsigned char*)lds;
    F.tid = threadIdx.x; F.lane = F.tid & 63; F.wave = __builtin_amdgcn_readfirstlane(F.tid >> 6);
    F.G = gridDim.x; { const int bx = blockIdx.x; F.vcu = (F.G % 8 == 0) ? (bx % 8) * (F.G / 8) + bx / 8 : bx; }
    F.a = &args;
    for (int u = F.tid; u < (LDS_BYTES - MISC_OFF) / 4; u += 512) ((LAS unsigned*)(F.lds + MISC_OFF))[u] = 0u;
    __syncthreads();
    XcdBarrier bar; bar.bar = F_ctl + CW_BAR; bar.x = 0; bar.st = nullptr;
    if (MK_N_LAUNCHES == 1) bar = xcd_barrier_post(F_ctl + CW_BAR, (volatile LAS unsigned*)(F.lds + MISC_OFF));
    const int lo = args.ph_lo, hi = args.ph_hi;
#define IN(k) (lo <= (k) && (k) < hi)
#define SEAM(k) do { if (MK_N_LAUNCHES == 1 && IN(k) && IN((k) + 1)) xcd_barrier(bar); } while (0)
    const int cx = (int)((blockIdx.x % 8) * (gridDim.x / 8) + blockIdx.x / 8);

    if (IN(0)) { ph0_mod(F); SEAM(0); }
    if (IN(1)) { ph0b_modsum(F); SEAM(1); }
    if (IN(2)) { ph1_prologue(F); SEAM(2); }
    if (IN(3)) {
        constexpr int NCOMP = 16;
        const int rank = (int)blockIdx.x >> 3, xcd = (int)blockIdx.x & 7;
        if (F.G != 256) {
            pg8::DenseOrder S; S.init(F_hb, F_WinT, T, DIN, F.G, (int)blockIdx.x);
            EpiInProj E{F_qb, F_kb, F_vb, F_glu, F_biasp, F_g_q, F_g_k};
            pg8::gemm_phase<EpiInProj, pg8::DenseOrder, false>(F.lds, F.lds + META_OFF, S, E, args.krep & 255);
            moe_convert(F, F.vcu * 8 + F.wave, F.G * 8, args.krep);
        } else if ((rank & 1) == 0) {
            pg8::DenseOrder S; S.init(F_hb, F_WinT, T, DIN, 8 * NCOMP, xcd + 8 * (rank >> 1));
            EpiInProj E{F_qb, F_kb, F_vb, F_glu, F_biasp, F_g_q, F_g_k};
            pg8::gemm_phase<EpiInProj, pg8::DenseOrder, false>(F.lds, F.lds + META_OFF, S, E, args.krep & 255);
        } else {
            moe_convert(F, ((xcd * (32 - NCOMP)) + (rank >> 1)) * 8 + F.wave, 8 * (32 - NCOMP) * 8, args.krep);
        }
        SEAM(3);
    }
    if (IN(4)) { for (int u = F.vcu; u < T / 64; u += F.G) ph3_unit(F, u, args.krep); SEAM(4); }
    if (IN(5)) {
        pg8::DenseOrderT<pg8::KB8> S; S.init(F_mix, F_WoutT, T, D, F.G, (int)blockIdx.x);
        EpiOut E{F_x, F_ra, F_modf, F_b_out, F_x1b};
        pg8::gemm_phase<EpiOut, pg8::DenseOrderT<pg8::KB8>, true>(F.lds, F.lds + META_OFF, S, E, args.krep & 255);
        SEAM(5);
    }
    if (IN(6)) { for (int it = blockIdx.x; it < T / 64; it += F.G) ph5_iter(F, it); SEAM(6); }
    if (IN(7)) {
        const int total = GU_MAIN(moe_tables(F, 16));
        pg8::MoeGatherT<pg8::KB8> S; S.tab = (const LAS int*)(F.lds + MISC_OFF + 64); S.npn = 16; S.G = F.G; S.c = cx; S.total = total; S.A = (const char*)F_h8; S.Bt = (const char*)F_WguT; S.bexp = (size_t)2 * D * D; S.list = F_list; S.cbase = F_cvgu; S.cexp = 4096;
#ifdef PROBE_KREP
        if (args.krep & 256) S.bexp = 0;
#endif
        EpiGU E{F_act};
        pg8::gemm_phase<EpiGU, pg8::MoeGatherT<pg8::KB8>, true>(F.lds, F.lds + META_OFF, S, E, args.krep & 255);
        SEAM(7);
    }
    if (IN(8)) {
        const int gu_total = moe_tables(F, 16), gu_main = GU_MAIN(gu_total), ov = gu_total - gu_main;
        if (cx < ov) {
            pg8::MoeGatherT<pg8::KB8> S; S.tab = (const LAS int*)(F.lds + MISC_OFF + 64); S.npn = 16; S.G = 1 << 24; S.c = gu_main + cx; S.total = gu_total; S.A = (const char*)F_h8; S.Bt = (const char*)F_WguT; S.bexp = (size_t)2 * D * D; S.list = F_list; S.cbase = F_cvgu; S.cexp = 4096;
            EpiGU E{F_act};
            pg8::gemm_phase<EpiGU, pg8::MoeGatherT<pg8::KB8>, true>(F.lds, F.lds + META_OFF, S, E, 1);
            if (F.tid == 0) { __builtin_amdgcn_fence(__ATOMIC_RELEASE, "agent"); asm volatile("s_waitcnt vmcnt(0)" ::: "memory"); (void)__hip_atomic_fetch_add(F_ctl + CW_OVF, 1u, RLX_AGENT); }
        }
        const int total = moe_tables(F, 8);
        pg8::MoeDenseT<pg8::KB8> S; S.tab = (const LAS int*)(F.lds + MISC_OFF + 64); S.npn = 8; S.G = F.G; S.c = (cx - ov + F.G) % F.G; S.total = total;
        S.dep_from = gu_main; S.dep_target = (unsigned)ov; S.dep_ctr = F_ctl + CW_OVF; S.dep_tmo = F_ctl + CW_TMO; S.A = (const char*)F_act; S.Bt = (const char*)F_WdnT; S.bexp = (size_t)D * D; S.list = F_list; S.cbase = F_b_down; S.cexp = D;
#ifdef PROBE_KREP
        if (args.krep & 256) S.bexp = 0;
#endif
        EpiDown E{F_part};
        pg8::gemm_phase<EpiDown, pg8::MoeDenseT<pg8::KB8>, true>(F.lds, F.lds + META_OFF, S, E, args.krep & 255);
        SEAM(8);
    }
    if (IN(9)) ph8_final(F);
#undef IN
#undef SEAM
}

extern "C" void kernel_launch(void* const* d_in, const int* in_sizes, int n_in, void* d_out, int out_size, void* d_ws, size_t ws_size, hipStream_t stream) {
    static int grid = 0;
    if (grid == 0) {
        if (n_in != 28 || out_size != T * D || ws_size < WS_END) { fprintf(stderr, "kernel_launch: unexpected shapes (n_in %d, out %d, ws %zu)\n", n_in, out_size, ws_size); grid = -1; return; }
        int dev = 0, cus = 0, per_cu = 0;
        if (hipGetDevice(&dev) != hipSuccess || hipDeviceGetAttribute(&cus, hipDeviceAttributeMultiprocessorCount, dev) != hipSuccess) { grid = -1; return; }
        if (hipFuncSetAttribute((const void*)fwd_kernel, hipFuncAttributeMaxDynamicSharedMemorySize, LDS_BYTES) != hipSuccess) { fprintf(stderr, "kernel_launch: hipFuncSetAttribute failed\n"); grid = -1; return; }
        if (hipOccupancyMaxActiveBlocksPerMultiprocessor(&per_cu, (const void*)fwd_kernel, 512, LDS_BYTES) != hipSuccess || per_cu < 1) { fprintf(stderr, "kernel_launch: occupancy query says %d\n", per_cu); (void)hipGetLastError(); }
        grid = cus;
    }
    if (grid < 0) return;
    (void)in_sizes;
    if (hipMemsetAsync((char*)d_ws + WS_CTL, 0, CTL_ZERO_BYTES, stream) != hipSuccess) return;
    Args a{};
    for (int i = 0; i < 28; ++i) a.in[i] = (const float*)d_in[i];
    a.out = (float*)d_out; a.ws = (unsigned char*)d_ws;
    a.krep = 1; a.pad = 0;
    if (MK_N_LAUNCHES == 1) { a.ph_lo = 0; a.ph_hi = NPHASE; hipLaunchKernelGGL(fwd_kernel, dim3(grid), dim3(512), LDS_BYTES, stream, a); }
    else for (int p = 0; p < NPHASE; ++p) { a.ph_lo = p; a.ph_hi = p + 1;
#ifdef DUP_PHASE
        if (p == DUP_PHASE) {
#ifdef PROBE_KREP
            a.krep = PROBE_KREP;
#endif
            hipLaunchKernelGGL(fwd_kernel, dim3(grid), dim3(512), LDS_BYTES, stream, a); a.krep = 1; }
#endif
        hipLaunchKernelGGL(fwd_kernel, dim3(grid), dim3(512), LDS_BYTES, stream, a);
    }
}
```

```cpp
#include <hip/hip_runtime.h>
#include <cstdio>
#include <cstdint>

#ifndef NCV7
#define NCV7 8
#endif
#ifndef NC3
#define NC3 11
#endif
#ifndef MK_N_LAUNCHES
#define MK_N_LAUNCHES 1
#endif

#define LAS __attribute__((address_space(3)))
#define GAS __attribute__((address_space(1)))
typedef unsigned short bf16;
typedef short bf16x8 __attribute__((ext_vector_type(8)));
typedef short s16x4 __attribute__((ext_vector_type(4)));
typedef float f32x4 __attribute__((ext_vector_type(4)));
typedef float f32x2 __attribute__((ext_vector_type(2)));
typedef unsigned u32x4 __attribute__((ext_vector_type(4)));
typedef unsigned u32x2 __attribute__((ext_vector_type(2)));
typedef int i32x4 __attribute__((ext_vector_type(4)));
typedef int i32x8 __attribute__((ext_vector_type(8)));
constexpr int W8_SHIFT = 5; constexpr int W8_SCALE_E8 = (127 - W8_SHIFT) * 0x01010101; constexpr float W8_MUL = 32.0f, W8_INV = 1.0f / 32.0f;
__device__ __forceinline__ unsigned pk_hi_lo_fp8(f32x2 lo, f32x2 hi) { unsigned w = __builtin_amdgcn_cvt_pk_fp8_f32(hi.x, hi.y, __float_as_uint(hi.x), true); return __builtin_amdgcn_cvt_pk_fp8_f32(lo.x, lo.y, w, false); }
__device__ __forceinline__ unsigned pk4_fp8(float a, float b, float c, float d) { unsigned w = 0u; w = __builtin_amdgcn_cvt_pk_fp8_f32(a, b, w, false); w = __builtin_amdgcn_cvt_pk_fp8_f32(c, d, w, true); return w; }

constexpr int T = 16384, D = 2048, DIN = 3328, DA = 1024, DKV = 128, DC = 1024, NE = 32, NH = 16;
constexpr int LCAP = 16384;
constexpr float EPS = 1e-6f, LOG2E = 1.4426950408889634f, QSCALE = 0.125f * 1.4426950408889634f;
constexpr int NPHASE = 11;

constexpr size_t MiB = 1u << 20;
constexpr size_t WS_CTL = 0, CTL_BYTES = 1 * MiB, CTL_ZERO_BYTES = 64 * 1024;
constexpr size_t WS_WIN = 2 * MiB;
constexpr size_t WS_WOUT = 16 * MiB;
constexpr size_t WS_MISC = 24 * MiB;
constexpr size_t WS_H = 32 * MiB;
constexpr size_t WS_Q = 96 * MiB;
constexpr size_t WS_K = 128 * MiB;
constexpr size_t WS_V = 132 * MiB;
constexpr size_t WS_GLU = 136 * MiB;
constexpr size_t WS_MIX = 168 * MiB;
constexpr size_t WS_WGU = 256 * MiB;
constexpr size_t WS_WDN = 512 * MiB;
constexpr size_t WS_ACT = 640 * MiB;
constexpr size_t WS_PART = 784 * MiB;
constexpr size_t WS_H8 = 1040 * MiB;
constexpr size_t WS_LIST = 1072 * MiB;
constexpr size_t WS_END = 1080 * MiB;
constexpr int CW_TMO = 0;
constexpr int CW_BAR = 4096;
constexpr int CW_CNT = 8192;
constexpr int CW_OVF = 10240;
constexpr int CW_MOD = 16384;
constexpr int CW_CVR = 28672;
constexpr int CW_CVGU = 65536;
static_assert((CW_CVGU + 32 * 4096) * 4 <= (int)CTL_BYTES && (CW_CNT + 32 * 64) * 4 <= (int)CTL_ZERO_BYTES && (CW_BAR + 3456) * 4 <= (int)CTL_ZERO_BYTES, "ctl");
constexpr size_t MS_BIASP = 0;
constexpr size_t MS_RA = 64 * 1024;
constexpr size_t MS_TOPW = 256 * 1024;
constexpr size_t MS_WR2 = 1 * MiB;
constexpr size_t MS_LIST = 2 * MiB;
constexpr size_t MS_MODP = 6 * MiB;

constexpr int RING_BYTES = 131072;
constexpr int META_OFF = 131840;
constexpr int MISC_OFF = 142336;
constexpr int LDS_BYTES = 143360;
constexpr int P3_K = 0, P3_V = 55296, P3_TAB = 110592, P3_SSQ = 118784, P3_RA = 131584, P3_CTP = 1028;

#define LDS_WAIT() asm volatile("s_waitcnt lgkmcnt(0)" ::: "memory")
#define VM_WAIT() asm volatile("s_waitcnt vmcnt(0)" ::: "memory")
#define RLX_AGENT __ATOMIC_RELAXED, __HIP_MEMORY_SCOPE_AGENT

__device__ __forceinline__ unsigned cvt_pk_bf16(float lo, float hi) { unsigned r; asm volatile("v_cvt_pk_bf16_f32 %0, %1, %2" : "=v"(r) : "v"(lo), "v"(hi)); return r; }
__device__ __forceinline__ float wave_sum(float v) {
#pragma unroll
    for (int o = 1; o < 64; o <<= 1) v += __shfl_xor(v, o);
    return v;
}
__device__ __forceinline__ void wave_sum4(float (&v)[4]) {
#pragma unroll
    for (int o = 1; o < 64; o <<= 1) {
#pragma unroll
        for (int k = 0; k < 4; ++k) v[k] += __shfl_xor(v[k], o); }
}
__device__ __forceinline__ float bf_lo(unsigned v) { return __builtin_bit_cast(float, v << 16); }
__device__ __forceinline__ float bf_hi(unsigned v) { return __builtin_bit_cast(float, v & 0xffff0000u); }

namespace pg8 {
constexpr int BM = 256, BK = 64, HALF = 128, HTB = HALF * BK * 2, STAGE_BYTES = 8 * HTB, NXCD = 8, WGM = 4;
constexpr int KB16 = 4096, KB8 = 2048;
__host__ __device__ __forceinline__ int lds_byte(int r, int c) { const int st = (r >> 4) * 2 + (c >> 5), rr = r & 15, cc = c & 31, ob = rr * 64 + cc * 2; return st * 1024 + (ob ^ (((ob >> 9) & 1) << 5)); }
__host__ __device__ __forceinline__ void stage_rc(int b, int& R, int& C) { const int st = b / 1024, sb = b % 1024, swz = sb ^ (((sb >> 9) & 1) << 5); R = (st >> 1) * 16 + swz / 64; C = (st & 1) * 32 + (swz % 64) / 2; }
__host__ __device__ __forceinline__ int perm32(int rho) { const int n = rho >> 4, i = rho & 15; return 8 * (i >> 2) + 4 * n + (i & 3); }

struct Unit { int pm, pn, e, m, nv, nt; };
constexpr size_t KSTEP = 128;

template <int KB> struct DenseOrderT {
    static constexpr bool META = false, DEP = false;
    static constexpr size_t HSTEP = (size_t)HALF * KB, TSTEP = 2 * HSTEP;
    const char* A; const char* Bt; int nM, nN, nwg, G, c;
    __device__ void init(const void* A_, const void* Bt_, int M, int N, int G_, int c_) { A = (const char*)A_; Bt = (const char*)Bt_; nM = M / BM; nN = N / BM; nwg = nM * nN; G = G_; c = c_; }
    __device__ __forceinline__ bool next(int i, Unit& u) const {
        const int L = i * G + c; if (L >= nwg) return false;
        int wgid = L; { const int q = nwg / NXCD, r = nwg % NXCD, xcd = wgid % NXCD, off = wgid / NXCD; wgid = (xcd < r ? xcd * (q + 1) : r * (q + 1) + (xcd - r) * q) + off; }
        const int nig = WGM * nN, gid = wgid / nig, fm = gid * WGM, gsz = (nM - fm) < WGM ? (nM - fm) : WGM;
        u.pm = fm + ((wgid % nig) % gsz); u.pn = (wgid % nig) / gsz; u.e = 0; u.m = 0; u.nv = 256; u.nt = 1; return true;
    }
    __device__ __forceinline__ const char* a_base(const Unit& u) const { return A + (size_t)u.pm * TSTEP; }
    __device__ __forceinline__ const char* b_base(const Unit& u) const { return Bt + (size_t)u.pn * TSTEP; }
    __device__ __forceinline__ void a_off(const Unit&, unsigned (&v)[2][2], int tid, const LAS unsigned char*) const {
        int R[2], C[2]; stage_rc(tid * 16, R[0], C[0]); stage_rc(tid * 16 + 8192, R[1], C[1]);
#pragma unroll
        for (int h = 0; h < 2; ++h)
#pragma unroll
            for (int i = 0; i < 2; ++i) v[h][i] = (unsigned)(h * (int)HSTEP) + (unsigned)(R[i] * KB + C[i] * 2);
    }
    __device__ __forceinline__ void meta_issue(const Unit&, LAS unsigned char*, LAS unsigned char*, int, int) const {}
};
typedef DenseOrderT<KB16> DenseOrder;
template <int KB> struct MoeOrderT {
    static constexpr bool META = true;
    static constexpr size_t HSTEP = (size_t)HALF * KB, TSTEP = 2 * HSTEP;
    const LAS int* tab; int npn, G, c, total, L0 = 0;
    const char* A; const char* Bt; size_t bexp; const u32x4* list; const float* cbase; int cexp;
    __device__ __forceinline__ bool next(int i, Unit& u) const {
        const int L = L0 + i * G + c; if (L >= total) return false;
        int e = 0;
        for (int j = 1; j < 32; ++j) e += (L >= tab[32 + j]) ? 1 : 0;
        e = __builtin_amdgcn_readfirstlane(e);
        const int p0 = __builtin_amdgcn_readfirstlane(tab[32 + e]), p1 = __builtin_amdgcn_readfirstlane(tab[33 + e]);
        const int cnt = __builtin_amdgcn_readfirstlane(tab[e]), t0 = __builtin_amdgcn_readfirstlane(tab[65 + e]);
        const int nt = (p1 - p0) / npn, rem = L - p0;
        u.pn = rem / nt; u.m = rem - u.pn * nt; u.e = e; u.nt = nt; u.pm = t0 + u.m; const int left = cnt - 256 * u.m; u.nv = left < 256 ? left : 256; return true;
    }
    __device__ __forceinline__ const char* b_base(const Unit& u) const { return Bt + (size_t)u.e * bexp + (size_t)u.pn * TSTEP; }
    __device__ __forceinline__ void meta_issue(const Unit& u, LAS unsigned char* eb, LAS unsigned char* cb, int wid, int lane) const {
        if (wid < 4) __builtin_amdgcn_global_load_lds((const unsigned*)(list + (size_t)u.e * LCAP + 256 * u.m + 64 * wid + lane), (LAS unsigned*)(eb + wid * 1024), 16, 0, 0);
        else if (wid == 4) __builtin_amdgcn_global_load_lds((const unsigned*)(cbase + (size_t)u.e * cexp + u.pn * 256 + 4 * lane), (LAS unsigned*)cb, 16, 0, 0);
    }
};
template <int KB> struct MoeGatherT : MoeOrderT<KB> {
    static constexpr bool DEP = false;
    using MoeOrderT<KB>::A;
    __device__ __forceinline__ const char* a_base(const Unit&) const { return A; }
    __device__ __forceinline__ void a_off(const Unit& u, unsigned (&v)[2][2], int tid, const LAS unsigned char* eb) const {
        int R[2], C[2]; stage_rc(tid * 16, R[0], C[0]); stage_rc(tid * 16 + 8192, R[1], C[1]);
#pragma unroll
        for (int h = 0; h < 2; ++h)
#pragma unroll
            for (int i = 0; i < 2; ++i) { const int pos = 128 * h + R[i]; unsigned ts = *(const LAS unsigned*)(eb + pos * 16); ts = pos < u.nv ? ts : 0u;
                v[h][i] = (ts >> 2) * (unsigned)KB + (unsigned)C[i] * 2u; }
    }
};
template <int KB> struct MoeDenseT : MoeOrderT<KB> {
    static constexpr bool DEP = true;
    int dep_from; unsigned dep_target; unsigned* dep_ctr; unsigned* dep_tmo;
    __device__ __forceinline__ bool dep(const Unit& u) const { return 16 * (u.pm - u.m) + 15 * u.nt + u.m >= dep_from; }
    __device__ __forceinline__ void dep_wait() const {
        unsigned sp = 0u;
        while (__hip_atomic_load(dep_ctr, __ATOMIC_RELAXED, __HIP_MEMORY_SCOPE_AGENT) < dep_target) { __builtin_amdgcn_s_sleep(1); if (++sp > (1u << 20)) { atomicAdd(dep_tmo, 1u); break; } }
        __builtin_amdgcn_fence(__ATOMIC_ACQUIRE, "agent");
        asm volatile("s_waitcnt vmcnt(0)" ::: "memory");
    }
    using MoeOrderT<KB>::A; using MoeOrderT<KB>::HSTEP; using MoeOrderT<KB>::TSTEP;
    __device__ __forceinline__ const char* a_base(const Unit& u) const { return A + (size_t)u.pm * TSTEP; }
    __device__ __forceinline__ void a_off(const Unit& u, unsigned (&v)[2][2], int tid, const LAS unsigned char*) const {
        int R[2], C[2]; stage_rc(tid * 16, R[0], C[0]); stage_rc(tid * 16 + 8192, R[1], C[1]);
#pragma unroll
        for (int h = 0; h < 2; ++h)
#pragma unroll
            for (int i = 0; i < 2; ++i) { const int pos = 128 * h + R[i];
                v[h][i] = (unsigned)((pos < u.nv ? pos : 0) * KB + C[i] * 2); }
    }
};

template <class Epi, class Sched, bool FP8>
__device__ __forceinline__ void gemm_phase(LAS unsigned char* lds, LAS unsigned char* meta, const Sched& S, const Epi& E, int krep = 1) {
    constexpr int KB = FP8 ? KB8 : KB16, NT = KB / 128;
    constexpr size_t HSTEP = (size_t)HALF * KB;
    const int tid = threadIdx.x, wid = __builtin_amdgcn_readfirstlane(tid >> 6), lane = tid & 63, wr = wid >> 2, wc = wid & 3, fr = lane & 15, fq = lane >> 4;
#ifdef PROBE_KREP
    const bool PG8_PROBE_NOSTAGE = (krep & 32) != 0, PG8_PROBE_NOMMA = (krep & 64) != 0, PG8_PROBE_NOEPI = (krep & 128) != 0; krep &= 15;
#else
    constexpr bool PG8_PROBE_NOSTAGE = false, PG8_PROBE_NOMMA = false, PG8_PROBE_NOEPI = false;
#endif
    unsigned voffB[2];
#pragma unroll
    for (int i = 0; i < 2; ++i) { int R, C; stage_rc(tid * 16 + i * 8192, R, C); const int Rb = Epi::PERM ? ((R & ~31) + perm32(R & 31)) : R;
        voffB[i] = (unsigned)(Rb * KB + C * 2); }
    const size_t kstep = KSTEP, hstep = HSTEP;
    const unsigned ldsw = (unsigned)wid * 1024u;
    const int aoff = lds_byte(wr * 64 + fr, fq * 8), boff = lds_byte(wc * 32 + fr, fq * 8);
#define PG8_SA(b, h) (((b) * 2 + (h)) * HTB)
#define PG8_SB(b, h) ((4 + (b) * 2 + (h)) * HTB)
#define PG8_STAGE(bufoff, gbase, voff) do { if (PG8_PROBE_NOSTAGE) break; _Pragma("unroll") for (int _i = 0; _i < 2; ++_i) \
        __builtin_amdgcn_global_load_lds((const unsigned*)((const char*)(gbase) + (voff)[_i]), (LAS unsigned*)(lds + (bufoff) + ldsw + _i * 8192), 16, 0, 0); } while (0)
#define PG8_LDA(dst, b, h) do { _Pragma("unroll") for (int m = 0; m < 4; ++m) { if constexpr (FP8) { dst##8[m].lo = *(const LAS i32x4*)(lds + PG8_SA(b, h) + aoff + m * 2048); dst##8[m].hi = *(const LAS i32x4*)(lds + PG8_SA(b, h) + aoff + m * 2048 + 1024); } \
        else { _Pragma("unroll") for (int k = 0; k < 2; ++k) dst[m][k] = *(const LAS bf16x8*)(lds + PG8_SA(b, h) + aoff + m * 2048 + k * 1024); } } } while (0)
#define PG8_LDB(dst, b, h) do { _Pragma("unroll") for (int n = 0; n < 2; ++n) { if constexpr (FP8) { dst##8[n].lo = *(const LAS i32x4*)(lds + PG8_SB(b, h) + boff + n * 2048); dst##8[n].hi = *(const LAS i32x4*)(lds + PG8_SB(b, h) + boff + n * 2048 + 1024); } \
        else { _Pragma("unroll") for (int k = 0; k < 2; ++k) dst[n][k] = *(const LAS bf16x8*)(lds + PG8_SB(b, h) + boff + n * 2048 + k * 1024); } } } while (0)
#define PG8_MMA(ai, bj, At, Bt) do { if (PG8_PROBE_NOMMA) break; __builtin_amdgcn_s_setprio(1); _Pragma("unroll") for (int m = 0; m < 4; ++m) _Pragma("unroll") for (int n = 0; n < 2; ++n) { \
        if constexpr (FP8) asm volatile("v_mfma_f32_16x16x128_f8f6f4 %0, %1, %2, %0" : "+v"(acc[ai][bj][m][n]) : "v"(Bt##8[n]), "v"(At##8[m])); \
        else { _Pragma("unroll") for (int k = 0; k < 2; ++k) acc[ai][bj][m][n] = __builtin_amdgcn_mfma_f32_16x16x32_bf16(Bt[n][k], At[m][k], acc[ai][bj][m][n], 0, 0, 0); } } \
        __builtin_amdgcn_s_setprio(0); } while (0)
#define PG8_WAIT_V(n) asm volatile("s_waitcnt vmcnt(" #n ")" ::: "memory")
#define PG8_WAIT_L(n) asm volatile("s_waitcnt lgkmcnt(" #n ")" ::: "memory")
#define PG8_BAR __builtin_amdgcn_s_barrier()
#define PG8_SCHED __builtin_amdgcn_sched_barrier(0)
    Unit cur, nxt; int ui = 0;
    if (!S.next(0, cur)) return;
    nxt = cur;
    f32x4 acc[2][2][4][2];
#pragma unroll
    for (int a = 0; a < 2; ++a)
#pragma unroll
        for (int b = 0; b < 2; ++b)
#pragma unroll
            for (int m = 0; m < 4; ++m)
#pragma unroll
                for (int n = 0; n < 2; ++n) acc[a][b][m][n] = (f32x4){0.f, 0.f, 0.f, 0.f};
    bf16x8 At[4][2], B0[2][2], B1[2][2]; i32x8 At8[4], B08[2], B18[2];
    unsigned cv[2][2], nv[2][2];
#define PG8_EB(par) (meta + (par) * 4096)
#define PG8_CB(par) (meta + 8192 + (par) * 1024)
    if constexpr (Sched::DEP) { if (S.dep(cur)) { if (wid == 7) S.dep_wait(); } }
    if constexpr (Sched::META) { S.meta_issue(cur, PG8_EB(0), PG8_CB(0), wid, lane); PG8_WAIT_V(0); PG8_BAR; }
    S.a_off(cur, cv, tid, PG8_EB(0));
#pragma unroll
    for (int h = 0; h < 2; ++h)
#pragma unroll
        for (int i = 0; i < 2; ++i) nv[h][i] = cv[h][i];
    const char* cA = S.a_base(cur); const char* cB = S.b_base(cur);
    PG8_STAGE(PG8_SB(0, 0), cB, voffB); PG8_STAGE(PG8_SB(0, 1), cB + hstep, voffB); PG8_STAGE(PG8_SA(0, 0), cA, cv[0]); PG8_STAGE(PG8_SA(0, 1), cA, cv[1]);
    if (wr == 1) PG8_BAR;
    PG8_WAIT_V(2); PG8_BAR;
    PG8_STAGE(PG8_SB(1, 0), cB + kstep, voffB); PG8_STAGE(PG8_SA(1, 0), cA + kstep, cv[0]); PG8_STAGE(PG8_SB(1, 1), cB + hstep + kstep, voffB);
    PG8_WAIT_V(6); PG8_BAR;
    for (;;) {
        const bool has_next = S.next(ui + 1, nxt);
        const char* nA = has_next ? S.a_base(nxt) : cA; const char* nB = has_next ? S.b_base(nxt) : cB;
#ifdef PROBE_KREP
        const int ntk = NT * krep;
#else
        constexpr int ntk = NT;
#endif
#pragma unroll 1
        for (int tt = 0; tt < ntk; tt += 2) {
            const int t = tt & (NT - 1);
            const bool last = (tt == ntk - 2);
            const char* a1 = cA + (size_t)(t + 1) * kstep;
            if (last && has_next) S.a_off(nxt, nv, tid, PG8_EB((ui + 1) & 1));
            const char* a2 = last ? nA : cA + (size_t)(t + 2) * kstep; const char* b2 = last ? nB : cB + (size_t)(t + 2) * kstep;
            const char* a3 = a2 + kstep; const char* b3 = b2 + kstep;
            unsigned s2[2][2];
#pragma unroll
            for (int h = 0; h < 2; ++h)
#pragma unroll
                for (int i = 0; i < 2; ++i) s2[h][i] = last ? nv[h][i] : cv[h][i];
            PG8_LDB(B0, 0, 0); PG8_LDB(B1, 0, 1); PG8_SCHED; PG8_LDA(At, 0, 0); PG8_STAGE(PG8_SA(1, 1), a1, cv[1]);
            PG8_WAIT_V(8); PG8_WAIT_L(0); PG8_BAR; PG8_MMA(0, 0, At, B0); PG8_MMA(0, 1, At, B1); PG8_BAR; PG8_SCHED;
            if constexpr (Sched::DEP) { if (tt == 0 && has_next && S.dep(nxt)) { if (wid == 7) S.dep_wait(); } }
            if constexpr (Sched::META) { if (tt == 0 && has_next) S.meta_issue(nxt, PG8_EB((ui + 1) & 1), PG8_CB((ui + 1) & 1), wid, lane); }
            PG8_LDA(At, 0, 1); PG8_STAGE(PG8_SB(0, 0), b2, voffB); PG8_STAGE(PG8_SB(0, 1), b2 + hstep, voffB); PG8_STAGE(PG8_SA(0, 0), a2, s2[0]);
            PG8_WAIT_V(8); PG8_WAIT_L(0); PG8_BAR; PG8_MMA(1, 0, At, B0); PG8_MMA(1, 1, At, B1); PG8_BAR; PG8_SCHED;
            PG8_LDB(B0, 1, 0); PG8_LDB(B1, 1, 1); PG8_SCHED; PG8_LDA(At, 1, 0); PG8_STAGE(PG8_SA(0, 1), a2, s2[1]);
            PG8_WAIT_V(8); PG8_WAIT_L(0); PG8_BAR; PG8_MMA(0, 0, At, B0); PG8_MMA(0, 1, At, B1); PG8_BAR; PG8_SCHED;
            PG8_LDA(At, 1, 1); PG8_STAGE(PG8_SB(1, 0), b3, voffB); PG8_STAGE(PG8_SB(1, 1), b3 + hstep, voffB); PG8_STAGE(PG8_SA(1, 0), a3, s2[0]);
            PG8_WAIT_V(8); PG8_WAIT_L(0); PG8_BAR; PG8_MMA(1, 0, At, B0); PG8_MMA(1, 1, At, B1); PG8_BAR; PG8_SCHED;
        }
        if (wr == 0) PG8_BAR;
        if constexpr (FP8) asm volatile("s_nop 15\n\ts_nop 7" ::: "memory");
        if (!PG8_PROBE_NOEPI) E(acc, cur, wr, wc, fr, fq, PG8_EB(ui & 1), PG8_CB(ui & 1));
        if (!has_next) break;
#pragma unroll
        for (int a = 0; a < 2; ++a)
#pragma unroll
            for (int b = 0; b < 2; ++b)
#pragma unroll
                for (int m = 0; m < 4; ++m)
#pragma unroll
                    for (int n = 0; n < 2; ++n) acc[a][b][m][n] = (f32x4){0.f, 0.f, 0.f, 0.f};
        cur = nxt; cA = nA; cB = nB; ++ui;
#pragma unroll
        for (int h = 0; h < 2; ++h)
#pragma unroll
            for (int i = 0; i < 2; ++i) cv[h][i] = nv[h][i];
        if (wr == 1) PG8_BAR;
    }
    PG8_WAIT_V(0);
    PG8_BAR;
#undef PG8_EB
#undef PG8_CB
#undef PG8_SA
#undef PG8_SB
#undef PG8_STAGE
#undef PG8_LDA
#undef PG8_LDB
#undef PG8_MMA
#undef PG8_WAIT_V
#undef PG8_WAIT_L
#undef PG8_BAR
#undef PG8_SCHED
}
}

#define XB_TMO      128
#define XB_XCNT(j)  (256  + 64 * (j))
#define XB_XSUB(j)  (1280 + 64 * (j))
#define XB_XGEN(j)  (2304 + 64 * (j))
#define XB_TOP      3328
#define XB_TOPGEN   3392
#define XCD_BAR_WORDS 3456
#define XB_SPIN_CAP (1u << 18)
__device__ __forceinline__ unsigned xb_ld(unsigned* p)              { return __hip_atomic_load(p, __ATOMIC_RELAXED, __HIP_MEMORY_SCOPE_AGENT); }
__device__ __forceinline__ unsigned xb_add(unsigned* p, unsigned v) { return __hip_atomic_fetch_add(p, v, __ATOMIC_RELAXED, __HIP_MEMORY_SCOPE_AGENT); }
__device__ __forceinline__ unsigned xb_xcc_id() { return (unsigned)__builtin_amdgcn_s_getreg((3 << 11) | 20) & 0xFu; }
#define XB_SPIN(cond, bar) do { unsigned _sp = 0; while (cond) { __builtin_amdgcn_s_sleep(1); \
    if ((++_sp & 255u) == 0u) { if (xb_ld(&(bar)[XB_TMO])) break; if (_sp > XB_SPIN_CAP) { atomicAdd(&(bar)[XB_TMO], 1u); break; } } } } while (0)
struct XcdBarrier { unsigned* bar; unsigned x; volatile LAS unsigned* st; };
__device__ __forceinline__ XcdBarrier xcd_barrier_post(unsigned* bar, volatile LAS unsigned* st) {
    XcdBarrier b; b.bar = bar; b.x = xb_xcc_id(); b.st = st;
    if (threadIdx.x == 0) (void)xb_add(&bar[XB_XCNT(b.x)], 1u);
    return b;
}
__device__ __forceinline__ void xcd_barrier_complete(unsigned* bar, unsigned x, unsigned& nloc, unsigned& nx) {
    const unsigned G = gridDim.x * gridDim.y * gridDim.z;
    unsigned sum, cnt, mine, sp = 0u;
    for (;;) {
        sum = 0u; cnt = 0u; mine = 0u;
#pragma unroll
        for (unsigned j = 0; j < 16; ++j) { const unsigned c = xb_ld(&bar[XB_XCNT(j)]); sum += c; cnt += (c > 0u) ? 1u : 0u; mine = (j == x) ? c : mine; }
        if (sum == G) break;
        __builtin_amdgcn_s_sleep(1);
        if ((++sp & 255u) == 0u) { if (xb_ld(&bar[XB_TMO])) break; if (sp > XB_SPIN_CAP) { atomicAdd(&bar[XB_TMO], 1u); break; } }
    }
    nloc = mine > 0u ? mine : 1u; nx = cnt > 0u ? cnt : 1u;
}
__device__ __forceinline__ void xcd_barrier(const XcdBarrier& b) {
    asm volatile("s_waitcnt vmcnt(0)" ::: "memory");
    __syncthreads();
    if (threadIdx.x == 0) {
        unsigned* bar = b.bar;
        __builtin_amdgcn_s_waitcnt(0);
        unsigned nloc = b.st[0], nx = b.st[1];
        if (nloc == 0u) { xcd_barrier_complete(bar, b.x, nloc, nx); b.st[0] = nloc; b.st[1] = nx; }
        const unsigned old = xb_add(&bar[XB_XSUB(b.x)], 1u);
        const unsigned gen = old / nloc;
        if (old + 1u == (gen + 1u) * nloc) {
            __builtin_amdgcn_fence(__ATOMIC_RELEASE, "agent");
            asm volatile("s_waitcnt vmcnt(0)" ::: "memory");
            const unsigned og = xb_add(&bar[XB_TOP], 1u);
            const unsigned tg = og / nx;
            if (og + 1u == (tg + 1u) * nx) xb_add(&bar[XB_TOPGEN], 1u);
            else XB_SPIN(xb_ld(&bar[XB_TOPGEN]) == tg, bar);
            __builtin_amdgcn_fence(__ATOMIC_ACQUIRE, "agent");
            xb_add(&bar[XB_XGEN(b.x)], 1u);
            asm volatile("s_waitcnt vmcnt(0)" ::: "memory");
        } else {
            XB_SPIN(xb_ld(&bar[XB_XGEN(b.x)]) == gen, bar);
            __builtin_amdgcn_fence(__ATOMIC_ACQUIRE, "agent");
            asm volatile("s_waitcnt vmcnt(0)" ::: "memory");
        }
    }
    __syncthreads();
}

struct Args { const float* in[28]; float* out; unsigned char* ws; int ph_lo, ph_hi, krep, pad; };
struct Frame {
    LAS unsigned char* lds;
    const Args* a;
    int tid, lane, wave, vcu, G;
};
#define F_IN(i) (F.a->in[i])
#define F_x F_IN(0)
#define F_c F_IN(1)
#define F_w_ada F_IN(2)
#define F_b_ada F_IN(3)
#define F_g_norm1 F_IN(4)
#define F_w_in F_IN(5)
#define F_b_in F_IN(6)
#define F_g_q F_IN(7)
#define F_g_k F_IN(8)
#define F_sinks F_IN(9)
#define F_rel_bias F_IN(10)
#define F_w_dw F_IN(11)
#define F_b_dw F_IN(12)
#define F_ln_g F_IN(13)
#define F_ln_b F_IN(14)
#define F_g_out_attn F_IN(15)
#define F_g_out_conv F_IN(16)
#define F_w_out F_IN(17)
#define F_b_out F_IN(18)
#define F_g_norm2 F_IN(19)
#define F_w_router F_IN(20)
#define F_b_router F_IN(21)
#define F_w_gate F_IN(22)
#define F_b_gate F_IN(23)
#define F_w_up F_IN(24)
#define F_b_up F_IN(25)
#define F_w_down F_IN(26)
#define F_b_down F_IN(27)
#define F_out (F.a->out)
#define F_ws (F.a->ws)
#define F_ctl ((unsigned*)(F_ws + WS_CTL))
#define F_WinT ((bf16*)(F_ws + WS_WIN))
#define F_WoutT ((bf16*)(F_ws + WS_WOUT))
#define F_WguT ((unsigned char*)(F_ws + WS_WGU))
#define F_WdnT ((unsigned char*)(F_ws + WS_WDN))
#define F_h8 ((unsigned char*)(F_ws + WS_H8))
#define F_hb ((bf16*)(F_ws + WS_H))
#define F_qb ((bf16*)(F_ws + WS_Q))
#define F_kb ((bf16*)(F_ws + WS_K))
#define F_vb ((bf16*)(F_ws + WS_V))
#define F_glu ((bf16*)(F_ws + WS_GLU))
#define F_x1b ((bf16*)(F_ws + WS_H))
#define F_mix ((unsigned char*)(F_ws + WS_MIX))
#define F_act ((unsigned char*)(F_ws + WS_ACT))
#define F_part ((bf16*)(F_ws + WS_PART))
#define F_modf ((float*)(F_ctl + CW_MOD))
#define F_modp ((float*)(F_ws + WS_MISC + MS_MODP))
#define F_cvr ((float*)(F_ctl + CW_CVR))
#define F_cvgu ((float*)(F_ctl + CW_CVGU))
#define F_biasp ((float*)(F_ws + WS_MISC + MS_BIASP))
#define F_ra ((float*)(F_ws + WS_MISC + MS_RA))
#define F_topw ((float*)(F_ws + WS_MISC + MS_TOPW))
#define F_wr2t ((bf16*)(F_ws + WS_MISC + MS_WR2))
#define F_list ((u32x4*)(F_ws + WS_LIST))
__device__ __forceinline__ float modv(const Frame& F, int i) { return F_modf[i]; }
__device__ __forceinline__ f32x4 modv4(const Frame& F, int i) { return *(const f32x4*)(F_modf + i); }

__device__ __forceinline__ void ph0_mod(Frame& F) {
    const int gw = F.vcu * 8 + F.wave, NGW = F.G * 8;
    for (int it = gw; it < 32 * 48; it += NGW) {
        const int kc = it / 48, ng = it % 48, k0 = kc * 64, n0 = ng * 256 + 4 * F.lane;
        const float cvv = F_c[k0 + F.lane]; const float sv = cvv / (1.f + __expf(-cvv));
        f32x4 a = (f32x4){0.f, 0.f, 0.f, 0.f};
#pragma unroll 16
        for (int kk = 0; kk < 64; ++kk) { const float s = __shfl(sv, kk); const f32x4 w = __builtin_nontemporal_load((const f32x4*)(F_w_ada + (size_t)(k0 + kk) * (6 * D) + n0)); a += s * w; }
        *(f32x4*)(F_modp + (size_t)kc * (6 * D) + n0) = a;
    }
}

__device__ __forceinline__ void ph0b_modsum(Frame& F) {
    const int gt = (F.vcu * 8 + F.wave) * 64 + F.lane;
    if (gt < 6 * D / 4) { f32x4 a = *(const f32x4*)(F_b_ada + 4 * gt);
#pragma unroll 8
        for (int kc = 0; kc < 32; ++kc) a += *(const f32x4*)(F_modp + (size_t)kc * (6 * D) + 4 * gt);
        *(f32x4*)(F_modf + 4 * gt) = a; }
}

template <bool CV, bool FP8W>
__device__ __forceinline__ void tr_item(const Frame& F, const float* W, int N, void* WTv, int c0, int k0, int n0, LAS float* scr, int lane, float* cvdst, const float* bias) {
#pragma unroll 8
    for (int i = 0; i < 32; ++i) { const int kk = 2 * i + (lane >> 5); scr[kk * 33 + (lane & 31)] = __builtin_nontemporal_load(W + (size_t)(k0 + kk) * N + n0 + (lane & 31)); }
    if (CV) scr[64 * 33 + lane] = modv(F, 3 * D + k0 + lane);
    LDS_WAIT(); asm volatile("" ::: "memory");
    const int c = lane & 7;
#pragma unroll
    for (int j = 0; j < 4; ++j) { const int n = (lane >> 3) + 8 * j; const LAS float* s = scr + (8 * c) * 33 + n;
        if (FP8W) { u32x2 o; o.x = pk4_fp8(s[0 * 33] * W8_MUL, s[1 * 33] * W8_MUL, s[2 * 33] * W8_MUL, s[3 * 33] * W8_MUL); o.y = pk4_fp8(s[4 * 33] * W8_MUL, s[5 * 33] * W8_MUL, s[6 * 33] * W8_MUL, s[7 * 33] * W8_MUL);
            *(u32x2*)((unsigned char*)WTv + (size_t)(c0 + n) * D + k0 + 8 * c) = o; }
        else { u32x4 o; o.x = cvt_pk_bf16(s[0 * 33], s[1 * 33]); o.y = cvt_pk_bf16(s[2 * 33], s[3 * 33]); o.z = cvt_pk_bf16(s[4 * 33], s[5 * 33]); o.w = cvt_pk_bf16(s[6 * 33], s[7 * 33]);
            *(u32x4*)((bf16*)WTv + (size_t)(c0 + n) * D + k0 + 8 * c) = o; } }
    if (CV) {
        const int n = lane & 31, hf = lane >> 5; float s = 0.f;
#pragma unroll 8
        for (int kk = 0; kk < 32; ++kk) s += scr[64 * 33 + 32 * hf + kk] * scr[(32 * hf + kk) * 33 + n];
        s += __shfl_xor(s, 32);
        if (lane < 32) { if (k0 == 0) s += bias[n0 + n]; atomicAdd(cvdst + c0 + n, s); }
    }
    LDS_WAIT(); asm volatile("" ::: "memory");
}
__device__ __forceinline__ int win_dst(int n0) {
    if (n0 < 1280) { const int pn = n0 >> 8, rem = n0 & 255, wc = rem >> 6, bj = (rem & 63) >> 5; return 256 * pn + 128 * bj + 32 * wc; }
    const int n1 = n0 - 1280, bj = n1 >> 10, n2 = n1 & 1023, j = n2 >> 7, wc = (n2 & 127) >> 5; return 256 * (5 + j) + 128 * bj + 32 * wc;
}
__device__ __forceinline__ int win_src(int c) {
    const int pn = c >> 8, bj = (c >> 7) & 1, wc = (c >> 5) & 3, i = c & 31;
    if (pn < 5) return 256 * pn + 64 * wc + 32 * bj + i;
    return 1280 + 1024 * bj + 128 * (pn - 5) + 32 * wc + i;
}
__device__ __forceinline__ int down_row(int sc) { return (sc & ~255) + 128 * ((sc >> 3) & 1) + 32 * ((sc >> 6) & 3) + 8 * ((sc >> 4) & 3) + (sc & 7); }
template <bool CV>
__device__ __forceinline__ void tr_moe_item(const float* W, unsigned char* WT, int c0, int n0, LAS float* scr, const LAS float* shl, int lane, float* cvdst, const float* bias, int probe = 0) {
    const int lr0 = lane >> 3, lc0 = lane & 7;
    const unsigned long long wbase = (unsigned long long)W;
    const unsigned wlo = __builtin_amdgcn_readfirstlane((unsigned)wbase), whi = __builtin_amdgcn_readfirstlane((unsigned)(wbase >> 32));
    const __amdgpu_buffer_rsrc_t rs = __builtin_amdgcn_make_buffer_rsrc((void*)(((unsigned long long)whi << 32) | wlo), 0, D * D * 4, 0x00020000);
    const unsigned loff = (unsigned)(lr0 * D + 4 * lc0 + n0) * 4u;
#define TR_LOAD(rowk) __builtin_bit_cast(f32x4, __builtin_amdgcn_raw_buffer_load_b128(rs, loff, (unsigned)(rowk) * (unsigned)(D * 4), 2))
#ifdef PROBE_KREP
    const int pr_rowmul = (probe & 256) ? 32 : D, pr_kmul = (probe & 256) ? 0 : 1;
#else
    constexpr int pr_rowmul = D, pr_kmul = 1;
#endif
    f32x4 pre[2][16];
#pragma unroll
    for (int q = 0; q < 2; ++q)
#pragma unroll
        for (int i = 0; i < 16; ++i) pre[q][i] = TR_LOAD(128 * q + 8 * i);
    f32x2 cvs[4] = {{0.f, 0.f}, {0.f, 0.f}, {0.f, 0.f}, {0.f, 0.f}};
#pragma unroll 1
    for (int kp2 = 0; kp2 < 16; kp2 += 2) {
#pragma unroll
        for (int q = 0; q < 2; ++q) {
            const int kp = kp2 + q, kn = kp + 2 < 16 ? kp + 2 : 15;
            int lc = lc0, lr = lr0; asm volatile("" : "+v"(lc), "+v"(lr));
#pragma unroll
            for (int i = 0; i < 16; ++i) *(LAS f32x4*)(scr + (8 * i + lr) * 32 + 4 * ((lc + (i >> 1)) & 7)) = pre[q][i];
#pragma unroll
            for (int i = 0; i < 16; ++i) pre[q][i] = TR_LOAD(128 * kn + 8 * i);
            LDS_WAIT(); asm volatile("" ::: "memory");
            f32x2 shv[8];
            if (CV) {
#pragma unroll
                for (int t = 0; t < 8; ++t) shv[t] = *(const LAS f32x2*)(shl + 128 * kp + 16 * lc + 2 * t);
            }
#pragma unroll
            for (int j = 0; j < 4; ++j) {
                const LAS float* col = scr + (16 * lc) * 32 + ((lr + 8 * j + 4 * lc) & 31);
                f32x2 pv[8];
#pragma unroll
                for (int t = 0; t < 8; ++t) { f32x2 r; r.x = col[(2 * t) * 32]; r.y = col[(2 * t + 1) * 32]; pv[t] = r * W8_MUL; }
                if (CV) {
#pragma unroll
                    for (int t = 0; t < 8; ++t) cvs[j] += shv[t] * pv[t];
                }
                u32x4 o;
                o.x = pk_hi_lo_fp8(pv[0], pv[1]); o.y = pk_hi_lo_fp8(pv[2], pv[3]); o.z = pk_hi_lo_fp8(pv[4], pv[5]); o.w = pk_hi_lo_fp8(pv[6], pv[7]);
                const unsigned roffj = (unsigned)((CV ? c0 + lr + 8 * j : down_row(n0 + lr + 8 * j)) * pr_rowmul + 16 * lc * pr_kmul);
                __builtin_nontemporal_store(o, (u32x4*)(WT + roffj + (size_t)(128 * kp) * pr_kmul));
            }
            LDS_WAIT(); asm volatile("" ::: "memory");
        }
    }
#undef TR_LOAD
    if (CV) {
#pragma unroll
        for (int j = 0; j < 4; ++j) { float t = (cvs[j].x + cvs[j].y) * (1.0f / W8_MUL); t += __shfl_xor(t, 1); t += __shfl_xor(t, 2); t += __shfl_xor(t, 4); if (lc0 == 0) cvdst[c0 + lr0 + 8 * j] = t + bias[n0 + lr0 + 8 * j]; }
    }
}
__device__ __forceinline__ void moe_convert(Frame& F, int gw, int NGW, int it_lo, int it_hi, int half, int probe = 0) {
    LAS float* scr = (LAS float*)(F.lds + F.wave * 16384);
    LAS float* shl = (LAS float*)(F.lds + 8 * 16384);
    const int lane = F.lane;
    for (int i = F.tid; i < D; i += 512) shl[i] = modv(F, 3 * D + i);
    __syncthreads();
    for (int jt = it_lo + gw; jt < it_hi; jt += NGW) {
        const int it = half < 0 ? jt : (jt & 1023) + 1024 * (2 * (jt >> 10) + half);
        const int nb = it & 63, e = (it >> 6) & 31, mat = it >> 11, n0 = 32 * nb;
#ifdef PROBE_KREP
        if (probe & 512) continue;
#endif
        if (mat == 2) tr_moe_item<false>(F_w_down + (size_t)e * D * D, F_WdnT + (size_t)e * D * D, n0, n0, scr, shl, lane, nullptr, nullptr, probe);
        else tr_moe_item<true>((mat ? F_w_up : F_w_gate) + (size_t)e * D * D, F_WguT + (size_t)e * 2 * D * D, 256 * (n0 >> 7) + 128 * mat + (n0 & 127), n0, scr, shl, lane, F_cvgu + e * 4096, (mat ? F_b_up : F_b_gate) + e * D, probe);
    }
    __syncthreads();
}
__device__ __forceinline__ void ph1_prologue(Frame& F) {
    LAS float* scr = (LAS float*)(F.lds + F.wave * 16384);
    const int gw = F.vcu * 8 + F.wave, NGW = F.G * 8, lane = F.lane;
    constexpr int I_IN = 32 * (DIN / 32), I_OUT = 32 * (D / 32);
    for (int it = gw; it < I_IN + I_OUT; it += NGW) {
        int r = it;
        if (r < I_IN) { const int nb = r % (DIN / 32), kb = r / (DIN / 32); tr_item<false, false>(F, F_w_in, DIN, F_WinT, win_dst(32 * nb), 64 * kb, 32 * nb, scr, lane, nullptr, nullptr); continue; } r -= I_IN;
        { const int nb = r % 64, kb = r / 64; tr_item<false, true>(F, F_w_out, D, F_WoutT, 32 * nb, 64 * kb, 32 * nb, scr, lane, nullptr, nullptr); }
    }
    {
        f32x4 ga[8], sh[8];
#pragma unroll
        for (int j = 0; j < 8; ++j) { const int cidx = 4 * lane + 256 * j; ga[j] = *(const f32x4*)(F_g_norm1 + cidx) * (modv4(F, D + cidx) + 1.0f); sh[j] = modv4(F, cidx); }
        for (int m = gw; m < T; m += NGW) {
            const f32x4* xr = (const f32x4*)(F_x + (size_t)m * D) + lane; f32x4 v[8]; float s = 0.f;
#pragma unroll
            for (int j = 0; j < 8; ++j) { v[j] = __builtin_nontemporal_load(xr + 64 * j); s += (v[j].x * v[j].x + v[j].y * v[j].y) + (v[j].z * v[j].z + v[j].w * v[j].w); }
            const float rn = __builtin_amdgcn_rsqf(wave_sum(s) * (1.f / D) + EPS);
            u32x2* o = (u32x2*)(F_hb + (size_t)m * D) + lane;
#pragma unroll
            for (int j = 0; j < 8; ++j) { const f32x4 y = v[j] * rn * ga[j] + sh[j]; u32x2 w; w.x = cvt_pk_bf16(y.x, y.y); w.y = cvt_pk_bf16(y.z, y.w); o[64 * j] = w; }
        }
    }
    const int gt = (F.vcu * 8 + F.wave) * 64 + lane, NGT = NGW * 64;
    for (int i = gt; i < DIN; i += NGT) F_biasp[i] = F_b_in[win_src(i)];
    for (int i = gt; i < D * NE; i += NGT) { const int k = i >> 5, e = i & 31; const float v = F_g_norm2[k] * (1.f + modv(F, 4 * D + k)) * F_w_router[i];
        const unsigned h0 = cvt_pk_bf16(v, 0.f) & 0xffffu; const float r1 = v - __uint_as_float(h0 << 16);
        const unsigned h1 = cvt_pk_bf16(r1, 0.f) & 0xffffu; const float r2 = r1 - __uint_as_float(h1 << 16);
        const unsigned h2 = cvt_pk_bf16(r2, 0.f) & 0xffffu;
        F_wr2t[(size_t)(0 * NE + e) * D + k] = (bf16)h0; F_wr2t[(size_t)(1 * NE + e) * D + k] = (bf16)h1; F_wr2t[(size_t)(2 * NE + e) * D + k] = (bf16)h2; }
    if (gw < NE) { float s = 0.f; for (int k = lane; k < D; k += 64) s += modv(F, 3 * D + k) * F_w_router[k * NE + gw]; s = wave_sum(s); if (lane == 0) F_cvr[gw] = s + F_b_router[gw]; }
}

struct EpiInProj {
    static constexpr bool PERM = true;
    bf16 *q, *k, *v, *glu; const float *biasp, *gq, *gk;
    __device__ __forceinline__ void operator()(const f32x4 (&acc)[2][2][4][2], const pg8::Unit& u, int wr, int wc, int fr, int fq, const LAS unsigned char* eb, const LAS unsigned char* cbuf) const {
        asm volatile("" : "+v"(fr), "+v"(fq));
        const int row0 = u.pm * 256 + wr * 64 + fr, cb = u.pn * 256 + wc * 32 + 8 * fq;
        f32x4 bv[2][2];
#pragma unroll
        for (int bj = 0; bj < 2; ++bj)
#pragma unroll
            for (int n = 0; n < 2; ++n) bv[bj][n] = *(const f32x4*)(biasp + cb + 128 * bj + 4 * n);
        if (u.pn < 5) {
            const bool isq = u.pn < 4, isk = (u.pn == 4) && (wc < 2), nrm = isq || isk;
            bf16* base = isq ? q : (isk ? k : v); const int ld = isq ? DA : DKV; const int hcol = isq ? (4 * u.pn + wc) * 64 : (isk ? wc * 64 : (wc - 2) * 64);
            const float* gp = isq ? gq : gk; const float sc = isq ? QSCALE : 1.0f;
            f32x4 gv[2][2];
#pragma unroll
            for (int bj = 0; bj < 2; ++bj)
#pragma unroll
                for (int n = 0; n < 2; ++n) gv[bj][n] = nrm ? *(const f32x4*)(gp + 32 * bj + 8 * fq + 4 * n) * sc : (f32x4){1.f, 1.f, 1.f, 1.f};
#pragma unroll
            for (int ai = 0; ai < 2; ++ai)
#pragma unroll
                for (int m = 0; m < 4; ++m) {
                    f32x4 xv[2][2]; float ss = 0.f;
#pragma unroll
                    for (int bj = 0; bj < 2; ++bj)
#pragma unroll
                        for (int n = 0; n < 2; ++n) { xv[bj][n] = acc[ai][bj][m][n] + bv[bj][n]; const f32x4 t = xv[bj][n]; ss += (t.x * t.x + t.y * t.y) + (t.z * t.z + t.w * t.w); }
                    ss += __shfl_xor(ss, 16); ss += __shfl_xor(ss, 32);
                    const float rn = nrm ? __builtin_amdgcn_rsqf(ss * (1.f / 64.f) + EPS) : 1.0f;
                    bf16* rowp = base + (size_t)(row0 + 128 * ai + 16 * m) * ld + hcol + 8 * fq;
#pragma unroll
                    for (int bj = 0; bj < 2; ++bj) { const f32x4 a = xv[bj][0] * rn * gv[bj][0], b = xv[bj][1] * rn * gv[bj][1];
                        u32x4 w; w.x = cvt_pk_bf16(a.x, a.y); w.y = cvt_pk_bf16(a.z, a.w); w.z = cvt_pk_bf16(b.x, b.y); w.w = cvt_pk_bf16(b.z, b.w);
                        *(u32x4*)(rowp + 32 * bj) = w; }
                }
        } else {
            const int ccol = 128 * (u.pn - 5) + 32 * wc + 8 * fq;
#pragma unroll
            for (int ai = 0; ai < 2; ++ai)
#pragma unroll
                for (int m = 0; m < 4; ++m) {
                    float o[8];
#pragma unroll
                    for (int n = 0; n < 2; ++n) { const f32x4 a = acc[ai][0][m][n] + bv[0][n], g = acc[ai][1][m][n] + bv[1][n];
#pragma unroll
                        for (int j = 0; j < 4; ++j) o[4 * n + j] = a[j] * __builtin_amdgcn_rcpf(1.f + __builtin_amdgcn_exp2f(-LOG2E * g[j])); }
                    u32x4 w; w.x = cvt_pk_bf16(o[0], o[1]); w.y = cvt_pk_bf16(o[2], o[3]); w.z = cvt_pk_bf16(o[4], o[5]); w.w = cvt_pk_bf16(o[6], o[7]);
                    *(u32x4*)(glu + (size_t)(row0 + 128 * ai + 16 * m) * DC + ccol) = w;
                }
        }
    }
};
struct EpiOut {
    static constexpr bool PERM = true;
    const float *x, *ra, *modf, *b_out; bf16* out;
    __device__ __forceinline__ void operator()(const f32x4 (&acc)[2][2][4][2], const pg8::Unit& u, int wr, int wc, int fr, int fq, const LAS unsigned char* eb, const LAS unsigned char* cbuf) const {
        asm volatile("" : "+v"(fr), "+v"(fq));
        const int row0 = u.pm * 256 + wr * 64 + fr, col0 = u.pn * 256 + wc * 32 + 8 * fq;
        f32x4 g1[2][2], bo[2][2];
#pragma unroll
        for (int bj = 0; bj < 2; ++bj)
#pragma unroll
            for (int n = 0; n < 2; ++n) { const int c = col0 + 128 * bj + 4 * n; g1[bj][n] = *(const f32x4*)(modf + 2 * D + c); bo[bj][n] = *(const f32x4*)(b_out + c); }
#pragma unroll
        for (int ai = 0; ai < 2; ++ai)
#pragma unroll
            for (int mp = 0; mp < 2; ++mp) {
                f32x4 xv[2][2][2]; float rs[2];
#pragma unroll
                for (int mm = 0; mm < 2; ++mm) { const int r = row0 + 128 * ai + 16 * (2 * mp + mm); rs[mm] = ra[r] * W8_INV; const size_t off = (size_t)r * D + col0;
#pragma unroll
                    for (int bj = 0; bj < 2; ++bj)
#pragma unroll
                        for (int n = 0; n < 2; ++n) xv[mm][bj][n] = __builtin_nontemporal_load((const f32x4*)(x + off + 128 * bj + 4 * n)); }
#pragma unroll
                for (int mm = 0; mm < 2; ++mm) { const int m = 2 * mp + mm; const size_t off = (size_t)(row0 + 128 * ai + 16 * m) * D + col0;
#pragma unroll
                    for (int bj = 0; bj < 2; ++bj) { const f32x4 v0 = xv[mm][bj][0] + g1[bj][0] * (acc[ai][bj][m][0] * rs[mm] + bo[bj][0]), v1 = xv[mm][bj][1] + g1[bj][1] * (acc[ai][bj][m][1] * rs[mm] + bo[bj][1]);
                        u32x4 w; w.x = cvt_pk_bf16(v0.x, v0.y); w.y = cvt_pk_bf16(v0.z, v0.w); w.z = cvt_pk_bf16(v1.x, v1.y); w.w = cvt_pk_bf16(v1.z, v1.w);
                        *(u32x4*)(out + off + 128 * bj) = w; } }
                asm volatile("" ::: "memory");
            }
    }
};
struct EpiGU {
    static constexpr bool PERM = true;
    unsigned char* act;
    __device__ __forceinline__ void operator()(const f32x4 (&acc)[2][2][4][2], const pg8::Unit& u, int wr, int wc, int fr, int fq, const LAS unsigned char* eb, const LAS unsigned char* cbuf) const {
        asm volatile("" : "+v"(fr), "+v"(fq));
        const int lrow0 = wr * 64 + fr; const LAS float* cvp = (const LAS float*)cbuf + wc * 32 + 8 * fq;
        f32x4 cg[2], cu[2];
#pragma unroll
        for (int n = 0; n < 2; ++n) { cg[n] = *(const LAS f32x4*)(cvp + 4 * n); cu[n] = *(const LAS f32x4*)(cvp + 128 + 4 * n); }
        float rsv[2][4];
#pragma unroll
        for (int ai = 0; ai < 2; ++ai)
#pragma unroll
            for (int m = 0; m < 4; ++m) rsv[ai][m] = *(const LAS float*)(eb + (lrow0 + 128 * ai + 16 * m) * 16 + 4) * W8_INV;
#pragma unroll
        for (int ai = 0; ai < 2; ++ai)
#pragma unroll
            for (int m = 0; m < 4; ++m) { const int lr = lrow0 + 128 * ai + 16 * m; const float rs = lr < u.nv ? rsv[ai][m] : 0.f;
                float o[8];
#pragma unroll
                for (int n = 0; n < 2; ++n) { const f32x4 g = acc[ai][0][m][n] * rs + cg[n], l = acc[ai][1][m][n] * rs + cu[n];
#pragma unroll
                    for (int j = 0; j < 4; ++j) { const float gg = fminf(g[j], 7.0f), ll = fminf(fmaxf(l[j], -7.0f), 7.0f);
                        o[4 * n + j] = gg * __builtin_amdgcn_rcpf(1.f + __builtin_amdgcn_exp2f(-1.702f * LOG2E * gg)) * (ll + 1.0f); } }
                u32x2 w; w.x = pk4_fp8(o[0], o[1], o[2], o[3]); w.y = pk4_fp8(o[4], o[5], o[6], o[7]);
                *(u32x2*)(act + (size_t)(u.pm * 256 + lr) * D + 128 * u.pn + 32 * wc + 8 * fq) = w; }
    }
};
struct EpiDown {
    static constexpr bool PERM = true;
    bf16* part;
    __device__ __forceinline__ void operator()(const f32x4 (&acc)[2][2][4][2], const pg8::Unit& u, int wr, int wc, int fr, int fq, const LAS unsigned char* eb, const LAS unsigned char* cbuf) const {
        asm volatile("" : "+v"(fr), "+v"(fq));
        const int lrow0 = wr * 64 + fr, col0 = u.pn * 256 + wc * 64 + 16 * fq;
        f32x4 bd[2][2];
#pragma unroll
        for (int bj = 0; bj < 2; ++bj)
#pragma unroll
            for (int n = 0; n < 2; ++n) bd[bj][n] = *(const LAS f32x4*)((const LAS float*)cbuf + wc * 64 + 16 * fq + 8 * bj + 4 * n) * W8_MUL;
        unsigned tsv[2][4]; float wsv[2][4];
#pragma unroll
        for (int ai = 0; ai < 2; ++ai)
#pragma unroll
            for (int m = 0; m < 4; ++m) { const u32x2 en = *(const LAS u32x2*)(eb + (lrow0 + 128 * ai + 16 * m) * 16); const unsigned wb = *(const LAS unsigned*)(eb + (lrow0 + 128 * ai + 16 * m) * 16 + 8); tsv[ai][m] = en.x; wsv[ai][m] = __uint_as_float(wb) * W8_INV; }
#pragma unroll
        for (int ai = 0; ai < 2; ++ai)
#pragma unroll
            for (int m = 0; m < 4; ++m) { const int lr = lrow0 + 128 * ai + 16 * m;
                if (lr < u.nv) { const unsigned ts = tsv[ai][m]; const float w8 = wsv[ai][m];
                    bf16* rowp = part + ((size_t)(ts & 3) * T + (ts >> 2)) * D + col0;
#pragma unroll
                    for (int bj = 0; bj < 2; ++bj) { const f32x4 a = (acc[ai][bj][m][0] + bd[bj][0]) * w8, b = (acc[ai][bj][m][1] + bd[bj][1]) * w8;
                        u32x4 w; w.x = cvt_pk_bf16(a.x, a.y); w.y = cvt_pk_bf16(a.z, a.w); w.z = cvt_pk_bf16(b.x, b.y); w.w = cvt_pk_bf16(b.z, b.w);
                        *(u32x4*)(rowp + 8 * bj) = w; } } }
    }
};

template <int I> struct ConvStep {
    static __device__ __forceinline__ void run(f32x2 (&o)[32], const f32x2 (&wv)[31], const bf16* glu, int rb, int c0) {
        const int row = rb - 30 + I; const int rc = row < 0 ? 0 : row; unsigned v = *(const unsigned*)(glu + (size_t)rc * DC + c0); v = row < 0 ? 0u : v;
        f32x2 xv; xv.x = bf_lo(v); xv.y = bf_hi(v);
#pragma unroll
        for (int j = 0; j < 31; ++j) { const int r = I - j; if (r >= 0 && r < 32) o[r] += wv[j] * xv; }
        ConvStep<I + 1>::run(o, wv, glu, rb, c0);
    }
};
template <> struct ConvStep<62> { static __device__ __forceinline__ void run(f32x2 (&)[32], const f32x2 (&)[31], const bf16*, int, int) {} };
__device__ __forceinline__ s16x4 vtr(const LAS unsigned char* p) { typedef short v4i16_t __attribute__((ext_vector_type(4))); return __builtin_bit_cast(s16x4, __builtin_amdgcn_ds_read_tr16_b64_v4i16((LAS v4i16_t*)p)); }
__device__ __forceinline__ void ph3_unit(Frame& F, int u, int probe = 0) {
    LAS unsigned char* L = F.lds;
    LAS unsigned char* Kl = L + P3_K; LAS unsigned char* Vl = L + P3_V; LAS float* tab = (LAS float*)(L + P3_TAB);
    LAS float* SSQ = (LAS float*)(L + P3_SSQ); LAS float* RA = (LAS float*)(L + P3_RA);
    const int tid = F.tid, lane = F.lane, w = F.wave, i16 = lane & 15, g4 = lane >> 4;
    const int q0 = u * 64, kbase = q0 - 128;
    for (int idx = tid; idx < 3072; idx += 512) { const int row = idx >> 4, ch = idx & 15, key = kbase + row; u32x4 kv = (u32x4){0u, 0u, 0u, 0u}, vv = kv;
        if (key >= 0) { kv = *(const u32x4*)(F_kb + (size_t)key * DKV + ch * 8); vv = *(const u32x4*)(F_vb + (size_t)key * DKV + ch * 8); }
        *(LAS u32x4*)(Kl + row * 288 + ch * 16) = kv; *(LAS u32x4*)(Vl + row * 288 + ch * 16) = vv; }
    for (int idx = tid; idx < 2048; idx += 512) { const int h = idx >> 7, d = idx & 127; int b = d;
        if (d >= 16) { b = 16 + (int)(logf((float)d * (1.f / 16.f)) / 2.0794415416798357f * 16.f); b = b > 31 ? 31 : b; }
        tab[idx] = F_rel_bias[b * NH + h] * LOG2E; }
    __syncthreads();
    bf16x8 nq0 = *(const bf16x8*)(F_qb + (size_t)(q0 + i16) * DA + w * 64 + 8 * g4), nq1 = *(const bf16x8*)(F_qb + (size_t)(q0 + i16) * DA + w * 64 + 32 + 8 * g4);
#pragma unroll 1
    for (int it = 0; it < 8; ++it) {
#ifdef PROBE_KREP
        if (probe & 256) break;
#endif
        const int hh = it >> 2, c = it & 3, h = w + 8 * hh; const float sink2 = F_sinks[h] * LOG2E;
        {
            const int t0 = c > 0 ? c - 1 : 0, qrow = q0 + 16 * c + i16;
            const bf16x8 qf0 = nq0, qf1 = nq1;
            { const int itn = it < 7 ? it + 1 : 7, hn = w + 8 * (itn >> 2), qn = q0 + 16 * (itn & 3) + i16;
              nq0 = *(const bf16x8*)(F_qb + (size_t)qn * DA + hn * 64 + 8 * g4); nq1 = *(const bf16x8*)(F_qb + (size_t)qn * DA + hn * 64 + 32 + 8 * g4); }
            f32x4 ga[4];
#pragma unroll
            for (int dt = 0; dt < 4; ++dt) ga[dt] = *(const f32x4*)(F_g_out_attn + h * 64 + 16 * dt + 4 * g4);
            f32x4 s[10];
#pragma unroll
            for (int tt = 0; tt < 10; ++tt) { const LAS unsigned char* kp = Kl + (16 * (t0 + tt) + i16) * 288 + (hh * 64 + 8 * g4) * 2;
                const bf16x8 k0 = *(const LAS bf16x8*)kp, k1 = *(const LAS bf16x8*)(kp + 64); f32x4 a = (f32x4){0.f, 0.f, 0.f, 0.f};
                a = __builtin_amdgcn_mfma_f32_16x16x32_bf16(k0, qf0, a, 0, 0, 0); a = __builtin_amdgcn_mfma_f32_16x16x32_bf16(k1, qf1, a, 0, 0, 0); s[tt] = a; }
            float mx = -1e30f;
#pragma unroll
            for (int tt = 0; tt < 10; ++tt)
#pragma unroll
                for (int r = 0; r < 4; ++r) { const int kk = 16 * (t0 + tt) + 4 * g4 + r, dist = 128 + 16 * c + i16 - kk; const bool valid = (dist >= 0) && (dist < 128) && (kbase + kk >= 0);
                    const float bb = tab[h * 128 + (valid ? dist : 0)]; const float sv = valid ? s[tt][r] + bb : -1e30f; s[tt][r] = sv; mx = fmaxf(mx, sv); }
            mx = fmaxf(mx, __shfl_xor(mx, 16)); mx = fmaxf(mx, __shfl_xor(mx, 32)); mx = fmaxf(mx, sink2);
            float l = 0.f;
#pragma unroll
            for (int tt = 0; tt < 10; ++tt)
#pragma unroll
                for (int r = 0; r < 4; ++r) { const float p = __builtin_amdgcn_exp2f(s[tt][r] - mx); s[tt][r] = p; l += p; }
            l += __shfl_xor(l, 16); l += __shfl_xor(l, 32);
            const float inv = 1.0f / (l + __builtin_amdgcn_exp2f(sink2 - mx));
            bf16x8 pf[5];
#pragma unroll
            for (int ks = 0; ks < 5; ++ks) { u32x4 w; w.x = cvt_pk_bf16(s[2 * ks][0], s[2 * ks][1]); w.y = cvt_pk_bf16(s[2 * ks][2], s[2 * ks][3]); w.z = cvt_pk_bf16(s[2 * ks + 1][0], s[2 * ks + 1][1]); w.w = cvt_pk_bf16(s[2 * ks + 1][2], s[2 * ks + 1][3]);
                pf[ks] = __builtin_bit_cast(bf16x8, w); }
            float ssq = 0.f;
#pragma unroll
            for (int dt = 0; dt < 4; ++dt) { f32x4 o = (f32x4){0.f, 0.f, 0.f, 0.f};
#pragma unroll
                for (int ks = 0; ks < 5; ++ks) { const LAS unsigned char* vp = Vl + (16 * (t0 + 2 * ks) + 4 * g4 + (i16 >> 2)) * 288 + (hh * 64 + 16 * dt + 4 * (i16 & 3)) * 2;
                    const s16x4 lo = vtr(vp), hi = vtr(vp + 16 * 288); bf16x8 vf; vf[0] = lo[0]; vf[1] = lo[1]; vf[2] = lo[2]; vf[3] = lo[3]; vf[4] = hi[0]; vf[5] = hi[1]; vf[6] = hi[2]; vf[7] = hi[3];
                    o = __builtin_amdgcn_mfma_f32_16x16x32_bf16(vf, pf[ks], o, 0, 0, 0); }
                o = o * inv; ssq += (o.x * o.x + o.y * o.y) + (o.z * o.z + o.w * o.w); o = o * ga[dt];
                *(unsigned*)(F_mix + (size_t)qrow * D + h * 64 + 16 * dt + 4 * g4) = pk4_fp8(o.x, o.y, o.z, o.w); }
            ssq += __shfl_xor(ssq, 16); ssq += __shfl_xor(ssq, 32);
            if (g4 == 0) SSQ[(hh * 8 + w) * 64 + 16 * c + i16] = ssq;
        }
    }
    __syncthreads();
    if (tid < 64) { float s = 0.f;
#pragma unroll
        for (int j = 0; j < 16; ++j) s += SSQ[j * 64 + tid];
        const float r = __builtin_amdgcn_rsqf(s * (1.f / DA) + EPS); RA[tid] = r; F_ra[q0 + tid] = r; }
    __syncthreads();
#ifdef PROBE_KREP
    if (probe & 512) return;
#endif
    LAS float* CT = (LAS float*)L;
    const int c0 = 2 * tid;
    f32x2 wv[31];
    { const float* wdw = F_w_dw + c0; asm volatile("" : "+v"(wdw));
#pragma unroll
    for (int j = 0; j < 31; ++j) wv[j] = *(const f32x2*)(wdw + j * DC); }
    const f32x2 bdw = *(const f32x2*)(F_b_dw + c0);
#pragma unroll 1
    for (int p = 0; p < 2; ++p) {
        const int rb = q0 + 32 * p;
        f32x2 o[32];
#pragma unroll
        for (int r = 0; r < 32; ++r) o[r] = bdw;
        ConvStep<0>::run(o, wv, F_glu, rb, c0);
#pragma unroll
        for (int r = 0; r < 32; ++r) *(LAS f32x2*)(CT + r * P3_CTP + c0) = o[r];
        __syncthreads();
#pragma unroll 1
        for (int rr = 0; rr < 4; ++rr) { const int r = 4 * w + rr, row = rb + r;
            f32x4 v[4]; float s1 = 0.f;
#pragma unroll
            for (int jj = 0; jj < 4; ++jj) { v[jj] = *(const LAS f32x4*)(CT + r * P3_CTP + 4 * lane + 256 * jj); s1 += (v[jj].x + v[jj].y) + (v[jj].z + v[jj].w); }
            const float mean = wave_sum(s1) * (1.f / DC); float s2 = 0.f;
#pragma unroll
            for (int jj = 0; jj < 4; ++jj) { v[jj] = v[jj] - mean; s2 += (v[jj].x * v[jj].x + v[jj].y * v[jj].y) + (v[jj].z * v[jj].z + v[jj].w * v[jj].w); }
            const float rstd = __builtin_amdgcn_rsqf(wave_sum(s2) * (1.f / DC) + EPS); float s3 = 0.f;
#pragma unroll
            for (int jj = 0; jj < 4; ++jj) { const int cc = 4 * lane + 256 * jj; const f32x4 y = v[jj] * rstd * *(const f32x4*)(F_ln_g + cc) + *(const f32x4*)(F_ln_b + cc); f32x4 z;
#pragma unroll
                for (int j = 0; j < 4; ++j) z[j] = y[j] * __builtin_amdgcn_rcpf(1.f + __builtin_amdgcn_exp2f(-LOG2E * y[j]));
                v[jj] = z; s3 += (z.x * z.x + z.y * z.y) + (z.z * z.z + z.w * z.w); }
            const float fac = __builtin_amdgcn_rsqf(wave_sum(s3) * (1.f / DC) + EPS) / RA[32 * p + r];
#pragma unroll
            for (int jj = 0; jj < 4; ++jj) { const int cc = 4 * lane + 256 * jj; const f32x4 z = v[jj] * fac * *(const f32x4*)(F_g_out_conv + cc);
                *(unsigned*)(F_mix + (size_t)row * D + DA + cc) = pk4_fp8(z.x, z.y, z.z, z.w); }
        }
        __syncthreads();
    }
}

__device__ __forceinline__ void ph5_iter(Frame& F, int it) {
    LAS float* P = (LAS float*)F.lds;
    LAS float* SS = P + 8 * 64 * 32;
    LAS int* LC = (LAS int*)(SS + 512);
    const int tid = F.tid, lane = F.lane, w = F.wave, i16 = lane & 15, g4 = lane >> 4, rb = 64 * it;
    if (tid < 64) LC[tid] = 0;
    f32x4 acc[4][2]; float ssl[4];
#pragma unroll
    for (int t = 0; t < 4; ++t) { acc[t][0] = (f32x4){0.f, 0.f, 0.f, 0.f}; acc[t][1] = acc[t][0]; ssl[t] = 0.f; }
#pragma unroll 1
    for (int blk = 0; blk < 4; ++blk) {
        const int kb = 256 * w + 64 * blk + 16 * g4;
        f32x4 gv[4];
#pragma unroll
        for (int jj = 0; jj < 4; ++jj) gv[jj] = *(const f32x4*)(F_g_norm2 + kb + 4 * jj) * (modv4(F, 4 * D + kb + 4 * jj) + 1.0f);
        u32x4 pa[4][2]; bf16x8 bw[3][2][2];
#pragma unroll
        for (int t = 0; t < 4; ++t)
#pragma unroll
            for (int h = 0; h < 2; ++h) pa[t][h] = *(const u32x4*)(F_x1b + (size_t)(rb + 16 * t + i16) * D + kb + 8 * h);
#pragma unroll
        for (int tm = 0; tm < 3; ++tm)
#pragma unroll
            for (int hf = 0; hf < 2; ++hf)
#pragma unroll
                for (int h = 0; h < 2; ++h) bw[tm][hf][h] = *(const bf16x8*)(F_wr2t + (size_t)(tm * NE + 16 * hf + i16) * D + kb + 8 * h);
#pragma unroll
        for (int t = 0; t < 4; ++t) { u32x4 w0; f32x4 y[4];
#pragma unroll
            for (int h = 0; h < 2; ++h) { const u32x4 pv = pa[t][h]; const f32x4 x0 = (f32x4){bf_lo(pv.x), bf_hi(pv.x), bf_lo(pv.y), bf_hi(pv.y)}, x1 = (f32x4){bf_lo(pv.z), bf_hi(pv.z), bf_lo(pv.w), bf_hi(pv.w)};
                ssl[t] += ((x0.x * x0.x + x0.y * x0.y) + (x0.z * x0.z + x0.w * x0.w)) + ((x1.x * x1.x + x1.y * x1.y) + (x1.z * x1.z + x1.w * x1.w)); y[2 * h] = x0 * gv[2 * h]; y[2 * h + 1] = x1 * gv[2 * h + 1]; }
            w0.x = pk4_fp8(y[0].x, y[0].y, y[0].z, y[0].w); w0.y = pk4_fp8(y[1].x, y[1].y, y[1].z, y[1].w); w0.z = pk4_fp8(y[2].x, y[2].y, y[2].z, y[2].w); w0.w = pk4_fp8(y[3].x, y[3].y, y[3].z, y[3].w);
            *(u32x4*)(F_h8 + (size_t)(rb + 16 * t + i16) * D + kb) = w0; }
#pragma unroll
        for (int tm = 2; tm >= 0; --tm)
#pragma unroll
            for (int h = 0; h < 2; ++h)
#pragma unroll
                for (int t = 0; t < 4; ++t)
#pragma unroll
                    for (int hf = 0; hf < 2; ++hf) acc[t][hf] = __builtin_amdgcn_mfma_f32_16x16x32_bf16(__builtin_bit_cast(bf16x8, pa[t][h]), bw[tm][hf][h], acc[t][hf], 0, 0, 0);
    }
    int i16b = i16, g4b = g4; asm volatile("" : "+v"(i16b), "+v"(g4b));
#pragma unroll
    for (int t = 0; t < 4; ++t) {
#pragma unroll
        for (int hf = 0; hf < 2; ++hf)
#pragma unroll
            for (int r = 0; r < 4; ++r) P[(w * 64 + 16 * t + 4 * g4b + r) * 32 + 16 * hf + i16b] = acc[t][hf][r];
        float v = ssl[t]; v += __shfl_xor(v, 16); v += __shfl_xor(v, 32); if (g4b == 0) SS[w * 64 + 16 * t + i16b] = v; }
    __syncthreads();
    int ek[4] = {0, 0, 0, 0}; int lr[4] = {0, 0, 0, 0}; float wk[4] = {0.f, 0.f, 0.f, 0.f}; float rr = 0.f; const int tok = rb + tid;
    if (tid < 64) {
        float lg[32]; float ssum = 0.f; int tidb = tid; asm volatile("" : "+v"(tidb));
#pragma unroll
        for (int e = 0; e < 32; ++e) lg[e] = 0.f;
#pragma unroll
        for (int ww = 0; ww < 8; ++ww) { ssum += SS[ww * 64 + tidb];
#pragma unroll
            for (int e4 = 0; e4 < 8; ++e4) { const f32x4 t4 = *(const LAS f32x4*)(P + (ww * 64 + tidb) * 32 + 4 * e4); lg[4 * e4] += t4.x; lg[4 * e4 + 1] += t4.y; lg[4 * e4 + 2] += t4.z; lg[4 * e4 + 3] += t4.w; } }
        rr = __builtin_amdgcn_rsqf(ssum * (1.f / D) + EPS);
#pragma unroll
        for (int e = 0; e < 32; ++e) lg[e] = lg[e] * rr + F_cvr[e];
        float vk[4];
#pragma unroll
        for (int k = 0; k < 4; ++k) { float best = -3.0e38f; int bi = 0;
#pragma unroll
            for (int e = 0; e < 32; ++e) { bool ok = lg[e] > best;
#pragma unroll
                for (int p = 0; p < 4; ++p) if (p < k) ok = ok && (ek[p] != e);
                best = ok ? lg[e] : best; bi = ok ? e : bi; }
            ek[k] = bi; vk[k] = best; }
        const float e1 = __expf(vk[1] - vk[0]), e2 = __expf(vk[2] - vk[0]), e3 = __expf(vk[3] - vk[0]); const float inv = 1.0f / (1.0f + e1 + e2 + e3);
        wk[0] = inv; wk[1] = e1 * inv; wk[2] = e2 * inv; wk[3] = e3 * inv;
#pragma unroll
        for (int k = 0; k < 4; ++k) lr[k] = __hip_atomic_fetch_add(LC + ek[k], 1, __ATOMIC_RELAXED, __HIP_MEMORY_SCOPE_WORKGROUP);
    }
    __syncthreads();
    if (tid < 32) { const int n = LC[tid]; int base = 0; if (n > 0) base = (int)__hip_atomic_fetch_add(F_ctl + CW_CNT + 64 * tid, (unsigned)n, RLX_AGENT); LC[32 + tid] = base; }
    __syncthreads();
    if (tid < 64) {
#pragma unroll
        for (int k = 0; k < 4; ++k) { const int pos = LC[32 + ek[k]] + lr[k]; u32x4 en; en.x = (unsigned)(tok * 4 + k); en.y = __float_as_uint(rr); en.z = __float_as_uint(wk[k]); en.w = 0u; F_list[(size_t)ek[k] * LCAP + pos] = en; }
    }
    __syncthreads();
}

__device__ __forceinline__ int moe_tables(Frame& F, int npn) {
    LAS int* tab = (LAS int*)(F.lds + MISC_OFF + 64);
    __syncthreads();
    int tl = F.tid; asm volatile("" : "+v"(tl));
    if (tl < 32) tab[tl] = (int)__hip_atomic_load(F_ctl + CW_CNT + 64 * tl, RLX_AGENT);
    __syncthreads();
    if (F.tid == 0) { int pu = 0, pt = 0; for (int e = 0; e < 32; ++e) { tab[32 + e] = pu; tab[65 + e] = pt; const int nt = (tab[e] + 255) >> 8; pu += nt * npn; pt += nt; } tab[64] = pu; tab[97] = pt; }
    __syncthreads();
    return __builtin_amdgcn_readfirstlane(tab[64]);
}

__device__ __forceinline__ void ph8_final(Frame& F) {
    const int gw = F.vcu * 8 + F.wave, NGW = F.G * 8, lane = F.lane;
    f32x4 g2[4][2];
#pragma unroll
    for (int jj = 0; jj < 4; ++jj)
#pragma unroll
        for (int q = 0; q < 2; ++q) g2[jj][q] = modv4(F, 5 * D + 8 * lane + 512 * jj + 4 * q);
    for (int row = gw; row < T; row += NGW) {
        u32x4 pv[4][4], xb[4];
#pragma unroll
        for (int jj = 0; jj < 4; ++jj) { const int col = 8 * lane + 512 * jj;
#pragma unroll
            for (int s = 0; s < 4; ++s) pv[jj][s] = __builtin_nontemporal_load((const u32x4*)(F_part + ((size_t)s * T + row) * D + col));
            xb[jj] = __builtin_nontemporal_load((const u32x4*)(F_x1b + (size_t)row * D + col)); }
#pragma unroll
        for (int jj = 0; jj < 4; ++jj) { const int col = 8 * lane + 512 * jj; float* op = F_out + (size_t)row * D + col;
            f32x4 a0 = (f32x4){0.f, 0.f, 0.f, 0.f}, a1 = a0;
#pragma unroll
            for (int s = 0; s < 4; ++s) { const u32x4 v = pv[jj][s];
                a0 += (f32x4){bf_lo(v.x), bf_hi(v.x), bf_lo(v.y), bf_hi(v.y)}; a1 += (f32x4){bf_lo(v.z), bf_hi(v.z), bf_lo(v.w), bf_hi(v.w)}; }
            const f32x4 x0 = (f32x4){bf_lo(xb[jj].x), bf_hi(xb[jj].x), bf_lo(xb[jj].y), bf_hi(xb[jj].y)}, x1 = (f32x4){bf_lo(xb[jj].z), bf_hi(xb[jj].z), bf_lo(xb[jj].w), bf_hi(xb[jj].w)};
            __builtin_nontemporal_store(x0 + g2[jj][0] * a0, (f32x4*)op); __builtin_nontemporal_store(x1 + g2[jj][1] * a1, (f32x4*)(op + 4)); }
    }
}

__device__ __forceinline__ void gu_half(Frame& F, int lo, int hi, int G7, int c, int krep) {
    pg8::MoeGatherT<pg8::KB8> S; S.tab = (const LAS int*)(F.lds + MISC_OFF + 64); S.npn = 16; S.G = G7; S.c = c; S.L0 = lo; S.total = hi; S.A = (const char*)F_h8; S.Bt = (const char*)F_WguT; S.bexp = (size_t)2 * D * D; S.list = F_list; S.cbase = F_cvgu; S.cexp = 4096;
    EpiGU E{F_act};
    pg8::gemm_phase<EpiGU, pg8::MoeGatherT<pg8::KB8>, true>(F.lds, F.lds + META_OFF, S, E, krep & 255);
}
__device__ __forceinline__ int gu_main_units(int total, int G7, int G8) {
#ifdef FORCE_OV
    return total - FORCE_OV;
#else
    const int dn = total >> 1, fr = total / G7, mainu = fr * G7, ov = total - mainu;
    if (ov == 0) return total;
    (void)dn; (void)G8;
    return mainu;
#endif
}

__global__ void __launch_bounds__(512, 2) fwd_kernel(Args args) {
    extern __shared__ __attribute__((aligned(16))) unsigned char lds[];
    Frame F;
    F.lds = (LAS unsigned char*)lds;
    F.tid = threadIdx.x; F.lane = F.tid & 63; F.wave = __builtin_amdgcn_readfirstlane(F.tid >> 6);
    F.G = gridDim.x; { const int bx = blockIdx.x; F.vcu = (F.G % 8 == 0) ? (bx % 8) * (F.G / 8) + bx / 8 : bx; }
    F.a = &args;
    for (int u = F.tid; u < (LDS_BYTES - MISC_OFF) / 4; u += 512) ((LAS unsigned*)(F.lds + MISC_OFF))[u] = 0u;
    __syncthreads();
    XcdBarrier bar; bar.bar = F_ctl + CW_BAR; bar.x = 0; bar.st = nullptr;
    if (MK_N_LAUNCHES == 1) bar = xcd_barrier_post(F_ctl + CW_BAR, (volatile LAS unsigned*)(F.lds + MISC_OFF));
    const int lo = args.ph_lo, hi = args.ph_hi;
#define IN(k) (lo <= (k) && (k) < hi)
#define SEAM(k) do { if (MK_N_LAUNCHES == 1 && IN(k) && IN((k) + 1)) xcd_barrier(bar); } while (0)
    const int cx = (int)((blockIdx.x % 8) * (gridDim.x / 8) + blockIdx.x / 8);

    if (IN(0)) { ph0_mod(F); SEAM(0); }
    if (IN(1)) { ph0b_modsum(F); SEAM(1); }
    if (IN(2)) { ph1_prologue(F); SEAM(2); }
    if (IN(3)) {
        const int rank = (int)blockIdx.x >> 3, xcd = (int)blockIdx.x & 7, cb3 = (rank * NC3) / 32;
        if (F.G != 256) {
            pg8::DenseOrder S; S.init(F_hb, F_WinT, T, DIN, F.G, (int)blockIdx.x);
            EpiInProj E{F_qb, F_kb, F_vb, F_glu, F_biasp, F_g_q, F_g_k};
            pg8::gemm_phase<EpiInProj, pg8::DenseOrder, false>(F.lds, F.lds + META_OFF, S, E, args.krep & 255);
            moe_convert(F, F.vcu * 8 + F.wave, F.G * 8, 0, 3 * NE * 64, -1, args.krep);
        } else if (((rank + 1) * NC3) / 32 == cb3) {
            pg8::DenseOrder S; S.init(F_hb, F_WinT, T, DIN, 8 * (32 - NC3), xcd + 8 * (rank - cb3));
            EpiInProj E{F_qb, F_kb, F_vb, F_glu, F_biasp, F_g_q, F_g_k};
            pg8::gemm_phase<EpiInProj, pg8::DenseOrder, false>(F.lds, F.lds + META_OFF, S, E, args.krep & 255);
        } else {
            moe_convert(F, ((xcd * NC3) + cb3) * 8 + F.wave, 8 * NC3 * 8, 0, 2048, 0, args.krep);
        }
        SEAM(3);
    }
    if (IN(4)) { for (int u = F.vcu; u < T / 64; u += F.G) ph3_unit(F, u, args.krep); SEAM(4); }
    if (IN(5)) {
        pg8::DenseOrderT<pg8::KB8> S; S.init(F_mix, F_WoutT, T, D, F.G, (int)blockIdx.x);
        EpiOut E{F_x, F_ra, F_modf, F_b_out, F_x1b};
        pg8::gemm_phase<EpiOut, pg8::DenseOrderT<pg8::KB8>, true>(F.lds, F.lds + META_OFF, S, E, args.krep & 255);
        SEAM(5);
    }
    if (IN(6)) { for (int it = blockIdx.x; it < T / 64; it += F.G) ph5_iter(F, it); SEAM(6); }
    if (IN(7) || IN(8)) {
        const bool split7 = (F.G == 256); const int rank = (int)blockIdx.x >> 3, xcd = (int)blockIdx.x & 7, G7 = split7 ? 256 - 8 * NCV7 : F.G;
        const int gu_total = moe_tables(F, 16), total = gu_main_units(gu_total, G7, F.G);
        const int pre16 = __builtin_amdgcn_readfirstlane(((const LAS int*)(F.lds + MISC_OFF + 64))[32 + 16]);
        int bnd = split7 ? (pre16 / G7) * G7 : total; bnd = bnd < total ? bnd : total;
        const int cbelow = (rank * NCV7) / 32;
        const bool conv = split7 && ((rank + 1) * NCV7) / 32 != cbelow;
        const int c7 = split7 ? xcd * (32 - NCV7) + (rank - cbelow) : cx, gwc = ((xcd * NCV7) + cbelow) * 8 + F.wave;
        if (IN(7)) { if (conv) moe_convert(F, gwc, 8 * NCV7 * 8, 0, 2048, 1, args.krep); else gu_half(F, 0, bnd, G7, c7, args.krep); SEAM(7); }
        if (IN(8)) { if (conv) moe_convert(F, gwc, 8 * NCV7 * 8, 2 * NE * 64, 3 * NE * 64, -1, args.krep); else gu_half(F, bnd, total, G7, c7, args.krep); SEAM(8); }
    }
    if (IN(9)) {
        const int gu_total = moe_tables(F, 16), gu_main = gu_main_units(gu_total, F.G == 256 ? 256 - 8 * NCV7 : F.G, F.G), ov = gu_total - gu_main;
        if (cx < ov) {
            pg8::MoeGatherT<pg8::KB8> S; S.tab = (const LAS int*)(F.lds + MISC_OFF + 64); S.npn = 16; S.G = 1 << 24; S.c = gu_main + cx; S.total = gu_total; S.A = (const char*)F_h8; S.Bt = (const char*)F_WguT; S.bexp = (size_t)2 * D * D; S.list = F_list; S.cbase = F_cvgu; S.cexp = 4096;
            EpiGU E{F_act};
            pg8::gemm_phase<EpiGU, pg8::MoeGatherT<pg8::KB8>, true>(F.lds, F.lds + META_OFF, S, E, 1);
            if (F.tid == 0) { __builtin_amdgcn_fence(__ATOMIC_RELEASE, "agent"); asm volatile("s_waitcnt vmcnt(0)" ::: "memory"); (void)__hip_atomic_fetch_add(F_ctl + CW_OVF, 1u, RLX_AGENT); }
        }
        const int total = moe_tables(F, 8);
        pg8::MoeDenseT<pg8::KB8> S; S.tab = (const LAS int*)(F.lds + MISC_OFF + 64); S.npn = 8; S.G = F.G; S.c = (cx - ov + F.G) % F.G; S.total = total;
        S.dep_from = gu_main; S.dep_target = (unsigned)ov; S.dep_ctr = F_ctl + CW_OVF; S.dep_tmo = F_ctl + CW_TMO; S.A = (const char*)F_act; S.Bt = (const char*)F_WdnT; S.bexp = (size_t)D * D; S.list = F_list; S.cbase = F_b_down; S.cexp = D;
        EpiDown E{F_part};
        pg8::gemm_phase<EpiDown, pg8::MoeDenseT<pg8::KB8>, true>(F.lds, F.lds + META_OFF, S, E, args.krep & 255);
        SEAM(9);
    }
    if (IN(10)) ph8_final(F);
#undef IN
#undef SEAM
}

extern "C" void kernel_launch(void* const* d_in, const int* in_sizes, int n_in, void* d_out, int out_size, void* d_ws, size_t ws_size, hipStream_t stream) {
    static int grid = 0;
    if (grid == 0) {
        if (n_in != 28 || out_size != T * D || ws_size < WS_END) { fprintf(stderr, "kernel_launch: unexpected shapes (n_in %d, out %d, ws %zu)\n", n_in, out_size, ws_size); grid = -1; return; }
        int dev = 0, cus = 0, per_cu = 0;
        if (hipGetDevice(&dev) != hipSuccess || hipDeviceGetAttribute(&cus, hipDeviceAttributeMultiprocessorCount, dev) != hipSuccess) { grid = -1; return; }
        if (hipFuncSetAttribute((const void*)fwd_kernel, hipFuncAttributeMaxDynamicSharedMemorySize, LDS_BYTES) != hipSuccess) { fprintf(stderr, "kernel_launch: hipFuncSetAttribute failed\n"); grid = -1; return; }
        if (hipOccupancyMaxActiveBlocksPerMultiprocessor(&per_cu, (const void*)fwd_kernel, 512, LDS_BYTES) != hipSuccess || per_cu < 1) { fprintf(stderr, "kernel_launch: occupancy query says %d\n", per_cu); (void)hipGetLastError(); }
        grid = cus;
    }
    if (grid < 0) return;
    (void)in_sizes;
    if (hipMemsetAsync((char*)d_ws + WS_CTL, 0, CTL_ZERO_BYTES, stream) != hipSuccess) return;
    Args a{};
    for (int i = 0; i < 28; ++i) a.in[i] = (const float*)d_in[i];
    a.out = (float*)d_out; a.ws = (unsigned char*)d_ws;
    a.krep = 1; a.pad = 0;
    if (MK_N_LAUNCHES == 1) { a.ph_lo = 0; a.ph_hi = NPHASE; hipLaunchKernelGGL(fwd_kernel, dim3(grid), dim3(512), LDS_BYTES, stream, a); }
    else for (int p = 0; p < NPHASE; ++p) { a.ph_lo = p; a.ph_hi = p + 1;
#ifdef DUP_PHASE
        if (p == DUP_PHASE) {
#ifdef PROBE_KREP
            a.krep = PROBE_KREP;
#endif
            hipLaunchKernelGGL(fwd_kernel, dim3(grid), dim3(512), LDS_BYTES, stream, a); a.krep = 1; }
#endif
        hipLaunchKernelGGL(fwd_kernel, dim3(grid), dim3(512), LDS_BYTES, stream, a);
    }
}
```
